# Optimizing an MI355X kernel written in HIP

```python
import jax, jax.numpy as jnp
from jax import lax
import numpy as np

D_MODEL = 1024
BATCH = 16
SEQ = 2048
DEPTH = 1
DEC_BATCH = 4
DEC_SEQ = 4096
PAST_LEN = 128

FNET_WIDTH = 512
FNET_GROUPS = 4
FNET_GROUP_DIM = FNET_WIDTH // FNET_GROUPS
SGU_WIDTH = 512
SGU_HEADS = 4
SGU_HEAD_DIM = SGU_WIDTH // SGU_HEADS
CHUNK = 128
EPS = 1e-6

IN_SIZES = (FNET_WIDTH, FNET_WIDTH, SGU_WIDTH, SGU_WIDTH, SGU_WIDTH, D_MODEL, D_MODEL)
IN_WIDTH = sum(IN_SIZES)
IN_SPLITS = tuple(int(v) for v in np.cumsum(IN_SIZES)[:-1])

kernel_name = "fnet_gmlp_gated_hybrid_encoder"


def rmsnorm(x, g):
    xf = x.astype(jnp.float32)
    y = xf * lax.rsqrt(jnp.mean(xf * xf, axis=-1, keepdims=True) + EPS)
    return (y * g.astype(jnp.float32)).astype(x.dtype)


def layernorm(x, g, b):
    xf = x.astype(jnp.float32)
    mu = jnp.mean(xf, axis=-1, keepdims=True)
    xc = xf - mu
    var = jnp.mean(xc * xc, axis=-1, keepdims=True)
    y = xc * lax.rsqrt(var + EPS) * g.astype(jnp.float32) + b.astype(jnp.float32)
    return y.astype(x.dtype)


def fourier_branch(a, w_fmix, b_fmix):
    B, S, _ = a.shape
    a4 = a.reshape(B, S, FNET_GROUPS, FNET_GROUP_DIM).astype(jnp.float32)
    f = jnp.fft.fft2(a4, axes=(1, 3), norm="ortho").real.astype(a.dtype)
    y = jnp.einsum("bsgc,gcd->bsgd", f, w_fmix) + b_fmix
    return y.reshape(B, S, FNET_WIDTH)


def sgu_branch(u, v, ln_g, ln_b, w_s, b_s):
    B, S, _ = v.shape
    v = layernorm(v, ln_g, ln_b)
    vc = v.reshape(B, S // CHUNK, CHUNK, SGU_HEADS, SGU_HEAD_DIM)
    mixed = jnp.einsum("hpq,bnqhc->bnphc", w_s, vc) + b_s.T[:, :, None]
    return u * mixed.reshape(B, S, SGU_WIDTH)


def layer(x, c, norm_g, w_ada, b_ada, w_in, w_fmix, b_fmix, sgu_ln_g, sgu_ln_b,
          w_s, b_s, w_pa, w_pb, w_out):
    mod = jax.nn.silu(c) @ w_ada + b_ada
    shift, scale, gate = jnp.split(mod, 3, axis=-1)
    h = rmsnorm(x, norm_g) * (1.0 + scale[:, None, :]) + shift[:, None, :]
    z = h @ w_in
    a, ga, u, v, gb, ma, mb = jnp.split(z, IN_SPLITS, axis=-1)
    y_a = fourier_branch(a, w_fmix, b_fmix) * jax.nn.silu(ga)
    y_b = sgu_branch(u, v, sgu_ln_g, sgu_ln_b, w_s, b_s) * jax.nn.silu(gb)
    merged = jax.nn.sigmoid(ma) * (y_a @ w_pa) + jax.nn.sigmoid(mb) * (y_b @ w_pb)
    out = merged @ w_out
    return x + gate[:, None, :] * out


def trunk(x, c, norm_g, w_ada, b_ada, w_in, w_fmix, b_fmix, sgu_ln_g, sgu_ln_b,
          w_s, b_s, w_pa, w_pb, w_out, final_g):
    for l in range(DEPTH):
        x = layer(x, c, norm_g[l], w_ada[l], b_ada[l], w_in[l], w_fmix[l], b_fmix[l],
                  sgu_ln_g[l], sgu_ln_b[l], w_s[l], b_s[l], w_pa[l], w_pb[l], w_out[l])
    return rmsnorm(x, final_g)


def setup_inputs(seed: int = 0) -> dict:
    key = jax.random.key(seed)
    ks = jax.random.split(key, 20)
    f32 = jnp.float32
    nrm = lambda k, shape, s: jax.random.normal(k, shape, f32) * s
    return {
        "x_prompt": nrm(ks[0], (BATCH, SEQ, D_MODEL), 1.0),
        "x_sample": nrm(ks[1], (DEC_BATCH, DEC_SEQ, D_MODEL), 1.0),
        "c_prompt": nrm(ks[2], (BATCH, D_MODEL), 1.0),
        "c_sample": nrm(ks[3], (DEC_BATCH, D_MODEL), 1.0),
        "norm_g": 1.0 + nrm(ks[4], (DEPTH, D_MODEL), 0.02),
        "w_ada": nrm(ks[5], (DEPTH, D_MODEL, 3 * D_MODEL), 0.3 * D_MODEL ** -0.5),
        "b_ada": nrm(ks[6], (DEPTH, 3 * D_MODEL), 0.02),
        "w_in": nrm(ks[7], (DEPTH, D_MODEL, IN_WIDTH), D_MODEL ** -0.5),
        "w_fmix": nrm(ks[8], (DEPTH, FNET_GROUPS, FNET_GROUP_DIM, FNET_GROUP_DIM), FNET_GROUP_DIM ** -0.5),
        "b_fmix": nrm(ks[9], (DEPTH, FNET_GROUPS, FNET_GROUP_DIM), 0.02),
        "sgu_ln_g": 1.0 + nrm(ks[10], (DEPTH, SGU_WIDTH), 0.02),
        "sgu_ln_b": nrm(ks[11], (DEPTH, SGU_WIDTH), 0.02),
        "w_s": nrm(ks[12], (DEPTH, SGU_HEADS, CHUNK, CHUNK), CHUNK ** -0.5),
        "b_s": 1.0 + nrm(ks[13], (DEPTH, SGU_HEADS, CHUNK), 0.02),
        "w_pa": nrm(ks[14], (DEPTH, FNET_WIDTH, D_MODEL), FNET_WIDTH ** -0.5),
        "w_pb": nrm(ks[15], (DEPTH, SGU_WIDTH, D_MODEL), SGU_WIDTH ** -0.5),
        "w_out": nrm(ks[16], (DEPTH, D_MODEL, D_MODEL), D_MODEL ** -0.5),
        "final_g": 1.0 + nrm(ks[17], (D_MODEL,), 0.02),
    }


def reference(x_prompt, x_sample, c_prompt, c_sample, norm_g, w_ada, b_ada, w_in, w_fmix, b_fmix,
              sgu_ln_g, sgu_ln_b, w_s, b_s, w_pa, w_pb, w_out, final_g):
    y_prompt = trunk(x_prompt, c_prompt, norm_g, w_ada, b_ada, w_in, w_fmix, b_fmix, sgu_ln_g,
                     sgu_ln_b, w_s, b_s, w_pa, w_pb, w_out, final_g)
    y_sample = trunk(x_sample, c_sample, norm_g, w_ada, b_ada, w_in, w_fmix, b_fmix, sgu_ln_g,
                     sgu_ln_b, w_s, b_s, w_pa, w_pb, w_out, final_g)
    return (y_prompt, y_sample)
```

```cpp
#include <hip/hip_runtime.h>
#include <hip/hip_cooperative_groups.h>
#include <cstdio>
namespace cg = cooperative_groups;

#define LAS __attribute__((address_space(3)))
typedef unsigned short bf16_t;
typedef short bf16x8 __attribute__((ext_vector_type(8)));
typedef float f32x4 __attribute__((ext_vector_type(4)));
typedef unsigned u32x4 __attribute__((ext_vector_type(4)));
typedef unsigned u32x2 __attribute__((ext_vector_type(2)));

constexpr int D = 1024;
constexpr int NTOK = 49152, NTOK_P = 32768;
constexpr int SP = 2048, SS = 4096;
constexpr int NB = 20;
constexpr int INW = 4608;
constexpr int LDS_BYTES = 131072 + 8192;

constexpr size_t OFF_MODP = 0;
constexpr size_t OFF_GATE = OFF_MODP + (size_t)8 * 20 * 3072 * 4;
constexpr size_t OFF_WT1  = OFF_GATE + (size_t)20 * 1024 * 4;
constexpr size_t OFF_WPA  = OFF_WT1 + (size_t)5120 * 1024 * 2;
constexpr size_t OFF_WPB  = OFF_WPA + (size_t)1024 * 512 * 2;
constexpr size_t OFF_WOUT = OFF_WPB + (size_t)1024 * 512 * 2;
constexpr size_t OFF_WSS  = OFF_WOUT + (size_t)1024 * 1024 * 2;
constexpr size_t OFF_D2   = OFF_WSS + (size_t)4 * 128 * 128 * 2;
constexpr size_t OFF_X1T  = OFF_D2 + (size_t)512 * 1024 * 2;
constexpr size_t OFF_ZR1  = OFF_X1T + (size_t)NTOK * 1024 * 2;
constexpr size_t OFF_ZR2  = OFF_ZR1 + (size_t)NTOK * 1024 * 2;
constexpr size_t OFF_VT   = OFF_ZR2 + (size_t)NTOK * 2048 * 2;
constexpr size_t OFF_GRN  = OFF_VT + (size_t)512 * NTOK * 2;
constexpr size_t GRN_WORDS = (size_t)192 * 4 * 4 * 256;
constexpr size_t OFF_BAR  = OFF_GRN + GRN_WORDS * 8;
constexpr size_t BAR_BYTES = 3456 * 4;
constexpr size_t WS_END   = OFF_BAR + BAR_BYTES;
constexpr size_t OUT_H  = 0;
constexpr size_t OUT_PT = (size_t)NTOK * 1024 * 2;
constexpr size_t OUT_PTS = OUT_PT + (size_t)16 * 512 * 2 * 2048 * 2;
constexpr size_t OUT_YA = 0;
constexpr size_t OUT_YB = (size_t)NTOK * 512 * 2;

struct Params {
    const float *x_p, *x_s, *c_p, *c_s, *norm_g, *w_ada, *b_ada, *w_in, *w_fmix, *b_fmix, *ln_g, *ln_b, *w_s, *b_s, *w_pa, *w_pb, *w_out, *final_g;
    float* out; unsigned char* ws;
};

#define TABI(i) ((i) + ((i) >> 5))
__device__ __forceinline__ int opaque_tid() { int t = threadIdx.x; asm volatile("" : "+v"(t)); return t; }
__device__ __forceinline__ unsigned cvt_pk_bf16(float lo, float hi) { unsigned r; asm volatile("v_cvt_pk_bf16_f32 %0, %1, %2" : "=v"(r) : "v"(lo), "v"(hi)); return r; }
__device__ __forceinline__ float bf_lo(unsigned w) { return __uint_as_float(w << 16); }
__device__ __forceinline__ float bf_hi(unsigned w) { return __uint_as_float(w & 0xffff0000u); }
__device__ __forceinline__ float sigm(float x) { return __builtin_amdgcn_rcpf(1.f + __builtin_amdgcn_exp2f(x * -1.4426950408889634f)); }
__device__ __forceinline__ float silu(float x) { return x * sigm(x); }
__device__ __forceinline__ float wave_sum(float v) {
#pragma unroll
    for (int o = 32; o > 0; o >>= 1) v += __shfl_xor(v, o, 64);
    return v;
}
__device__ __forceinline__ const float* xrow(const Params& p, int token) {
    return token < NTOK_P ? p.x_p + (size_t)token * D : p.x_s + (size_t)(token - NTOK_P) * D;
}
__device__ __forceinline__ int batch_of(int token) { return token < NTOK_P ? (token >> 11) : 16 + ((token - NTOK_P) >> 12); }

namespace pg8 {
constexpr int BM = 256, BK = 64, HALF = 128, HTB = HALF * BK * 2, NXCD = 8, WGM = 8;
__device__ __forceinline__ int lds_byte(int r, int c) { const int st = (r >> 4) * 2 + (c >> 5), rr = r & 15, cc = c & 31, ob = rr * 64 + cc * 2; return st * 1024 + (ob ^ (((ob >> 9) & 1) << 5)); }
__device__ __forceinline__ void stage_rc(int b, int& R, int& C) { const int st = b / 1024, sb = b % 1024, swz = sb ^ (((sb >> 9) & 1) << 5); R = (st >> 1) * 16 + swz / 64; C = (st & 1) * 32 + (swz % 64) / 2; }
__device__ __forceinline__ int perm32(int rho) { const int n = rho >> 4, i = rho & 15; return 8 * (i >> 2) + 4 * n + (i & 3); }

struct Unit { const char* A; const char* B; int pm, pn, kind, pad; };

__device__ __forceinline__ void tile_map(int L, int nM, int nN, int& pm, int& pn) {
    const int nwg = nM * nN; int wgid = L;
    { const int q = nwg / NXCD, r = nwg % NXCD, xcd = wgid % NXCD, off = wgid / NXCD; wgid = (xcd < r ? xcd * (q + 1) : r * (q + 1) + (xcd - r) * q) + off; }
    const int nig = WGM * nN, gid = wgid / nig, fm = gid * WGM, gsz = (nM - fm) < WGM ? (nM - fm) : WGM;
    pm = fm + ((wgid % nig) % gsz); pn = (wgid % nig) / gsz;
}

template <class Epi, class Sched>
__device__ __forceinline__ void gemm_phase(LAS unsigned char* lds, const int K, const Sched& S, const Epi& E) {
    const int tid = opaque_tid(), wid = __builtin_amdgcn_readfirstlane(tid >> 6), lane = tid & 63, wr = wid >> 2, wc = wid & 3, fr = lane & 15, fq = lane >> 4;
    const int nt = K / BK;
    unsigned voffA[2], voffB[2];
#pragma unroll
    for (int i = 0; i < 2; ++i) { int R, C; stage_rc(tid * 16 + i * 8192, R, C); const int Rb = Epi::PERM ? ((R & ~31) + perm32(R & 31)) : R;
        voffA[i] = (unsigned)(R * K + C) * 2u; voffB[i] = (unsigned)(Rb * K + C) * 2u; }
    const size_t kstep = (size_t)(BK * 2);
    const size_t hstep = (size_t)HALF * K * 2;
    const unsigned ldsw = (unsigned)wid * 1024u;
    const int aoff = lds_byte(wr * 64 + fr, fq * 8), boff = lds_byte(wc * 32 + fr, fq * 8);
#define PG8_SA(b, h) (((b) * 2 + (h)) * HTB)
#define PG8_SB(b, h) ((4 + (b) * 2 + (h)) * HTB)
#define PG8_STAGE(bufoff, gbase, voff) do { _Pragma("unroll") for (int _i = 0; _i < 2; ++_i) \
        __builtin_amdgcn_global_load_lds((const unsigned*)((const char*)(gbase) + (voff)[_i]), (LAS unsigned*)(lds + (bufoff) + ldsw + _i * 8192), 16, 0, 0); } while (0)
#define PG8_LDA(dst, b, h) do { _Pragma("unroll") for (int m = 0; m < 4; ++m) _Pragma("unroll") for (int k = 0; k < 2; ++k) dst[m][k] = *(const LAS bf16x8*)(lds + PG8_SA(b, h) + aoff + m * 2048 + k * 1024); } while (0)
#define PG8_LDB(dst, b, h) do { _Pragma("unroll") for (int n = 0; n < 2; ++n) _Pragma("unroll") for (int k = 0; k < 2; ++k) dst[n][k] = *(const LAS bf16x8*)(lds + PG8_SB(b, h) + boff + n * 2048 + k * 1024); } while (0)
#define PG8_MMA(ai, bj, At, Bt) do { __builtin_amdgcn_s_setprio(1); _Pragma("unroll") for (int m = 0; m < 4; ++m) _Pragma("unroll") for (int n = 0; n < 2; ++n) _Pragma("unroll") for (int k = 0; k < 2; ++k) \
        acc[ai][bj][m][n] = __builtin_amdgcn_mfma_f32_16x16x32_bf16(Bt[n][k], At[m][k], acc[ai][bj][m][n], 0, 0, 0); __builtin_amdgcn_s_setprio(0); } while (0)
#define PG8_WAIT_V(n) asm volatile("s_waitcnt vmcnt(" #n ")" ::: "memory")
#define PG8_WAIT_L(n) asm volatile("s_waitcnt lgkmcnt(" #n ")" ::: "memory")
#define PG8_BAR __builtin_amdgcn_s_barrier()
#define PG8_SCHED __builtin_amdgcn_sched_barrier(0)
    Unit cur, nxt; int ui = 0;
    if (!S.next(0, cur)) return;
    f32x4 acc[2][2][4][2];
#pragma unroll
    for (int a = 0; a < 2; ++a)
#pragma unroll
        for (int b = 0; b < 2; ++b)
#pragma unroll
            for (int m = 0; m < 4; ++m)
#pragma unroll
                for (int n = 0; n < 2; ++n) acc[a][b][m][n] = (f32x4){0.f, 0.f, 0.f, 0.f};
    bf16x8 At[4][2], B0[2][2], B1[2][2];
    const char* cA = cur.A; const char* cB = cur.B;
    PG8_STAGE(PG8_SB(0, 0), cB, voffB); PG8_STAGE(PG8_SA(0, 0), cA, voffA); PG8_STAGE(PG8_SB(0, 1), cB + hstep, voffB); PG8_STAGE(PG8_SA(0, 1), cA + hstep, voffA);
    if (wr == 1) PG8_BAR;
    PG8_WAIT_V(4); PG8_BAR;
    PG8_STAGE(PG8_SB(1, 0), cB + kstep, voffB); PG8_STAGE(PG8_SA(1, 0), cA + kstep, voffA); PG8_STAGE(PG8_SB(1, 1), cB + hstep + kstep, voffB);
    PG8_WAIT_V(6); PG8_BAR;
    for (;;) {
        const bool has_next = S.next(ui + 1, nxt);
        const char* nA = has_next ? nxt.A : cA; const char* nB = has_next ? nxt.B : cB;
        for (int t = 0; t < nt; t += 2) {
            const bool last = (t == nt - 2);
            const char* a1 = cA + (size_t)(t + 1) * kstep;
            const char* a2 = last ? nA : cA + (size_t)(t + 2) * kstep; const char* b2 = last ? nB : cB + (size_t)(t + 2) * kstep;
            const char* a3 = a2 + kstep; const char* b3 = b2 + kstep;
            PG8_LDB(B0, 0, 0); PG8_SCHED; PG8_LDA(At, 0, 0); PG8_STAGE(PG8_SA(1, 1), a1 + hstep, voffA);
            PG8_WAIT_L(8); PG8_BAR; PG8_WAIT_L(0); PG8_MMA(0, 0, At, B0); PG8_BAR; PG8_SCHED;
            PG8_LDB(B1, 0, 1); PG8_STAGE(PG8_SB(0, 0), b2, voffB);
            PG8_BAR; PG8_WAIT_L(0); PG8_MMA(0, 1, At, B1); PG8_BAR;
            PG8_LDA(At, 0, 1); PG8_STAGE(PG8_SA(0, 0), a2, voffA);
            PG8_BAR; PG8_WAIT_L(0); PG8_MMA(1, 0, At, B0); PG8_BAR; PG8_SCHED;
            PG8_STAGE(PG8_SB(0, 1), b2 + hstep, voffB);
            PG8_WAIT_V(6); PG8_BAR; PG8_MMA(1, 1, At, B1); PG8_BAR;
            PG8_LDB(B0, 1, 0); PG8_SCHED; PG8_LDA(At, 1, 0); PG8_STAGE(PG8_SA(0, 1), a2 + hstep, voffA);
            PG8_WAIT_L(8); PG8_BAR; PG8_WAIT_L(0); PG8_MMA(0, 0, At, B0); PG8_BAR; PG8_SCHED;
            PG8_LDB(B1, 1, 1); PG8_STAGE(PG8_SB(1, 0), b3, voffB);
            PG8_BAR; PG8_WAIT_L(0); PG8_MMA(0, 1, At, B1); PG8_BAR;
            PG8_LDA(At, 1, 1); PG8_STAGE(PG8_SA(1, 0), a3, voffA);
            PG8_BAR; PG8_WAIT_L(0); PG8_MMA(1, 0, At, B0); PG8_BAR; PG8_SCHED;
            PG8_STAGE(PG8_SB(1, 1), b3 + hstep, voffB);
            PG8_WAIT_V(6); PG8_BAR; PG8_MMA(1, 1, At, B1); PG8_BAR;
        }
        E(acc, cur, wr, wc, fr, fq);
        if (!has_next) break;
        if (!Epi::OWN_ACC && !(cur.kind & 1)) {
#pragma unroll
            for (int a = 0; a < 2; ++a)
#pragma unroll
                for (int b = 0; b < 2; ++b)
#pragma unroll
                    for (int m = 0; m < 4; ++m)
#pragma unroll
                        for (int n = 0; n < 2; ++n) acc[a][b][m][n] = (f32x4){0.f, 0.f, 0.f, 0.f};
        }
        cur = nxt; cA = nA; cB = nB; ++ui;
    }
    PG8_WAIT_V(0);
    if (wr == 0) PG8_BAR;
    PG8_BAR;
#undef PG8_SA
#undef PG8_SB
#undef PG8_STAGE
#undef PG8_LDA
#undef PG8_LDB
#undef PG8_MMA
#undef PG8_WAIT_V
#undef PG8_WAIT_L
#undef PG8_BAR
#undef PG8_SCHED
}
}
using pg8::Unit;

__device__ __forceinline__ u32x4 pack8(const f32x4& a, const f32x4& b) {
    u32x4 o; o[0] = cvt_pk_bf16(a[0], a[1]); o[1] = cvt_pk_bf16(a[2], a[3]); o[2] = cvt_pk_bf16(b[0], b[1]); o[3] = cvt_pk_bf16(b[2], b[3]); return o;
}

struct SchedG1 {
    const char* H; const char* WT1; int G, c;
    __device__ __forceinline__ bool next(int i, Unit& u) const {
        const long L = (long)i * G + c;
        if (L < 2688) { int pm, pn; pg8::tile_map((int)L, 192, 14, pm, pn); u.pm = pm; u.pn = pn; u.kind = 0; u.pad = 0;
            u.A = H + (size_t)pm * 256 * 1024 * 2; u.B = WT1 + (size_t)(1536 + pn * 256) * 1024 * 2; return true; }
        if (L < 3840) { int pm, pn; pg8::tile_map((int)(L - 2688), 6, 192, pm, pn); u.pm = pm; u.pn = pn; u.kind = 2; u.pad = 0;
            u.A = WT1 + (size_t)pm * 256 * 1024 * 2; u.B = H + (size_t)pn * 256 * 1024 * 2; return true; }
        return false;
    }
};
struct EpiG1 {
    static constexpr bool OWN_ACC = false;
    static constexpr bool PERM = true;
    bf16_t *ZR1, *ZR2, *PTp, *PTs, *VT;
    __device__ __forceinline__ void operator()(f32x4 (&acc)[2][2][4][2], const Unit& u, int wr, int wc, int fr_, int fq_) const {
        int fr = fr_, fq = fq_; asm volatile("" : "+v"(fr), "+v"(fq));
        if (u.kind == 0 && u.pn < 2) {
            bf16_t* base = ZR1 + u.pn * 256;
            const int row0 = u.pm * 256 + wr * 64 + fr, col0 = wc * 32 + 8 * fq;
#pragma unroll
            for (int ai = 0; ai < 2; ++ai)
#pragma unroll
                for (int m = 0; m < 4; ++m) { bf16_t* rowp = base + (size_t)(row0 + ai * 128 + m * 16) * 1024 + col0;
#pragma unroll
                    for (int bj = 0; bj < 2; ++bj) { f32x4 o0, o1;
#pragma unroll
                        for (int q = 0; q < 4; ++q) { o0[q] = silu(acc[ai][bj][m][0][q]); o1[q] = silu(acc[ai][bj][m][1][q]); }
                        *(u32x4*)(rowp + bj * 128) = pack8(o0, o1); } }
        } else if (u.kind == 0 && u.pn < 6) {
            const int row0 = u.pm * 256 + wr * 64 + fr, col0 = 512 + (u.pn - 2) * 128 + wc * 32 + 8 * fq;
#pragma unroll
            for (int ai = 0; ai < 2; ++ai)
#pragma unroll
                for (int m = 0; m < 4; ++m) { f32x4 o0, o1;
#pragma unroll
                    for (int q = 0; q < 4; ++q) { o0[q] = acc[ai][0][m][0][q] * silu(acc[ai][1][m][0][q]); o1[q] = acc[ai][0][m][1][q] * silu(acc[ai][1][m][1][q]); }
                    *(u32x4*)(ZR1 + (size_t)(row0 + ai * 128 + m * 16) * 1024 + col0) = pack8(o0, o1); }
        } else if (u.kind == 0) {
            const int row0 = u.pm * 256 + wr * 64 + fr, col0 = (u.pn - 6) * 128 + wc * 32 + 8 * fq;
#pragma unroll
            for (int ai = 0; ai < 2; ++ai)
#pragma unroll
                for (int m = 0; m < 4; ++m) { bf16_t* rowp = ZR2 + (size_t)(row0 + ai * 128 + m * 16) * 2048 + col0;
                    f32x4 r0, r1, s0, s1;
#pragma unroll
                    for (int q = 0; q < 4; ++q) {
                        const float ea0 = __builtin_amdgcn_exp2f(acc[ai][0][m][0][q] * -1.4426950408889634f), ea1 = __builtin_amdgcn_exp2f(acc[ai][0][m][1][q] * -1.4426950408889634f);
                        const float eb0 = __builtin_amdgcn_exp2f(acc[ai][1][m][0][q] * -1.4426950408889634f), eb1 = __builtin_amdgcn_exp2f(acc[ai][1][m][1][q] * -1.4426950408889634f);
                        const float pa0 = 1.f + ea0, pb0 = 1.f + eb0, pa1 = 1.f + ea1, pb1 = 1.f + eb1;
                        const float t0 = __builtin_amdgcn_rcpf(pa0 * pb0), t1 = __builtin_amdgcn_rcpf(pa1 * pb1);
                        s0[q] = pa0 * t0; s1[q] = pa1 * t1; r0[q] = pb0 * pb0 * t0; r1[q] = pb1 * pb1 * t1; }
                    __builtin_nontemporal_store(pack8(r0, r1), (u32x4*)rowp); __builtin_nontemporal_store(pack8(s0, s1), (u32x4*)(rowp + 1024)); }
        } else {
#pragma unroll
            for (int bj = 0; bj < 2; ++bj) {
                const int t = u.pn * 256 + bj * 128 + wc * 32 + 8 * fq;
                bf16_t* base; size_t colstride, partstride;
                if (t < NTOK_P) { const int b = t >> 11, s = t & 2047; base = PTp + (size_t)b * 512 * 4096 + s; colstride = 4096; partstride = 2048; }
                else { const int tt = t - NTOK_P, b = tt >> 12, s = tt & 4095; base = PTs + (size_t)b * 512 * 4096 + s; colstride = 4096; partstride = (size_t)4 * 512 * 4096; }
#pragma unroll
                for (int ai = 0; ai < 2; ++ai)
#pragma unroll
                    for (int m = 0; m < 4; ++m) { const int r = u.pm * 256 + ai * 128 + wr * 64 + m * 16 + fr, part = r >> 9, col = r & 511;
                        bf16_t* dst = (u.pm < 4) ? base + (size_t)col * colstride + (size_t)part * partstride : VT + (size_t)col * NTOK + t;
                        *(u32x4*)dst = pack8(acc[ai][bj][m][0], acc[ai][bj][m][1]); }
            }
        }
    }
};

struct SchedD2 {
    const char *D2, *X1T; int G, c;
    __device__ __forceinline__ bool next(int i, Unit& u) const {
        const long L = (long)i * G + c;
        if (L >= 384) return false;
        u.pm = (int)L & 1; u.pn = (int)L >> 1; u.kind = 0; u.pad = 0;
        u.A = D2 + (size_t)u.pm * 256 * 1024 * 2; u.B = X1T + (size_t)u.pn * 256 * 1024 * 2; return true;
    }
};
struct EpiD2 {
    static constexpr bool OWN_ACC = false;
    static constexpr bool PERM = true;
    const bf16_t* ZR1; bf16_t* YA; const float* b_fmix;
    __device__ __forceinline__ void operator()(f32x4 (&acc)[2][2][4][2], const Unit& u, int wr, int wc, int fr_, int fq_) const {
        int fr = fr_, fq = fq_; asm volatile("" : "+v"(fr), "+v"(fq));
#pragma unroll
        for (int bj = 0; bj < 2; ++bj) {
            const int n = u.pn * 256 + bj * 128 + wc * 32 + 8 * fq, col = n & 511;
            int k1, tokb, n1;
            if (n < 32768) { k1 = n >> 13; tokb = ((n >> 9) & 15) * SP; n1 = 4; }
            else { const int nn = n - 32768; k1 = nn >> 11; tokb = NTOK_P + ((nn >> 9) & 3) * SS; n1 = 8; }
            const f32x4 bv0 = *(const f32x4*)(b_fmix + col), bv1 = *(const f32x4*)(b_fmix + col + 4);
            u32x4 gv[2][4];
#pragma unroll
            for (int ai = 0; ai < 2; ++ai)
#pragma unroll
                for (int m = 0; m < 4; ++m) { const int k2 = u.pm * 256 + ai * 128 + wr * 64 + m * 16 + fr; gv[ai][m] = __builtin_nontemporal_load((const u32x4*)(ZR1 + (size_t)(tokb + k1 + n1 * k2) * 1024 + col)); }
#pragma unroll
            for (int ai = 0; ai < 2; ++ai)
#pragma unroll
                for (int m = 0; m < 4; ++m) { const int k2 = u.pm * 256 + ai * 128 + wr * 64 + m * 16 + fr; const size_t token = (size_t)(tokb + k1 + n1 * k2);
                    const u32x4 g = gv[ai][m];
                    f32x4 v0 = acc[ai][bj][m][0] + bv0, v1 = acc[ai][bj][m][1] + bv1;
                    v0[0] *= bf_lo(g[0]); v0[1] *= bf_hi(g[0]); v0[2] *= bf_lo(g[1]); v0[3] *= bf_hi(g[1]);
                    v1[0] *= bf_lo(g[2]); v1[1] *= bf_hi(g[2]); v1[2] *= bf_lo(g[3]); v1[3] *= bf_hi(g[3]);
                    *(u32x4*)(YA + token * 512 + col) = pack8(v0, v1); }
        }
    }
};

template <int W8> __device__ __forceinline__ void cmac8(float& xr, float& xi, float zr, float zi) {
    constexpr float R = 0.70710678118654752f;
    if (W8 == 0) { xr += zr; xi += zi; }
    else if (W8 == 1) { xr += R * (zr + zi); xi += R * (zi - zr); }
    else if (W8 == 2) { xr += zi; xi -= zr; }
    else if (W8 == 3) { xr += R * (zi - zr); xi -= R * (zi + zr); }
    else if (W8 == 4) { xr -= zr; xi -= zi; }
    else if (W8 == 5) { xr -= R * (zr + zi); xi += R * (zr - zi); }
    else if (W8 == 6) { xr -= zi; xi += zr; }
    else { xr += R * (zr - zi); xi += R * (zr + zi); }
}
template <int N1, int NP, int K1, int S1> struct DftAcc {
    static __device__ __forceinline__ void run(float (&xr)[NP], float (&xi)[NP], const float (&zr)[N1][NP], const float (&zi)[N1][NP]) {
#pragma unroll
        for (int j = 0; j < NP; ++j) cmac8<((K1 * S1) % N1) * (8 / N1)>(xr[j], xi[j], zr[S1][j], zi[S1][j]);
        if constexpr (S1 + 1 < N1) DftAcc<N1, NP, K1, S1 + 1>::run(xr, xi, zr, zi);
    }
};
template <int N1, int NP, int K1> struct DftK {
    static __device__ __forceinline__ void run(const float (&zr)[N1][NP], const float (&zi)[N1][NP], const float* tab, int s20, float scale, bf16_t* dst, size_t k1stride) {
        constexpr int SEQ = N1 * 512;
        float xr[NP], xi[NP];
#pragma unroll
        for (int j = 0; j < NP; ++j) { xr[j] = 0.f; xi[j] = 0.f; }
        DftAcc<N1, NP, K1, 0>::run(xr, xi, zr, zi);
        float yr[NP], yi[NP];
#pragma unroll
        for (int j = 0; j < NP; ++j) { const int ti = ((K1 * (s20 + j)) & (SEQ - 1)) * (4096 / SEQ);
            const float ct = tab[TABI(ti)] * scale, st = tab[TABI((ti - 1024) & 4095)] * scale;
            yr[j] = ct * xr[j] + st * xi[j]; yi[j] = ct * xi[j] - st * xr[j]; }
        bf16_t* d = dst + (size_t)K1 * k1stride;
        if constexpr (NP == 8) { u32x4 o0, o1;
#pragma unroll
            for (int j = 0; j < 4; ++j) { o0[j] = cvt_pk_bf16(yr[2 * j], yr[2 * j + 1]); o1[j] = cvt_pk_bf16(yi[2 * j], yi[2 * j + 1]); }
            *(u32x4*)d = o0; *(u32x4*)(d + 512) = o1;
        } else { u32x2 o0, o1;
#pragma unroll
            for (int j = 0; j < 2; ++j) { o0[j] = cvt_pk_bf16(yr[2 * j], yr[2 * j + 1]); o1[j] = cvt_pk_bf16(yi[2 * j], yi[2 * j + 1]); }
            *(u32x2*)d = o0; *(u32x2*)(d + 512) = o1; }
        if constexpr (K1 + 1 < N1) DftK<N1, NP, K1 + 1>::run(zr, zi, tab, s20, scale, dst, k1stride);
    }
};
template <int N1, int NP> __device__ __forceinline__ void dft1_item(const bf16_t* re, const bf16_t* im, const float* tab, int s20, float scale, bf16_t* dst, size_t k1stride) {
    float zr[N1][NP], zi[N1][NP];
    if constexpr (NP == 8) {
        u32x4 a[N1], b[N1];
#pragma unroll
        for (int s1 = 0; s1 < N1; ++s1) { a[s1] = __builtin_nontemporal_load((const u32x4*)(re + 512 * s1 + s20)); b[s1] = __builtin_nontemporal_load((const u32x4*)(im + 512 * s1 + s20)); }
#pragma unroll
        for (int s1 = 0; s1 < N1; ++s1)
#pragma unroll
            for (int j = 0; j < 4; ++j) { zr[s1][2 * j] = bf_lo(a[s1][j]); zr[s1][2 * j + 1] = bf_hi(a[s1][j]); zi[s1][2 * j] = -bf_lo(b[s1][j]); zi[s1][2 * j + 1] = -bf_hi(b[s1][j]); }
    } else {
        u32x2 a[N1], b[N1];
#pragma unroll
        for (int s1 = 0; s1 < N1; ++s1) { a[s1] = __builtin_nontemporal_load((const u32x2*)(re + 512 * s1 + s20)); b[s1] = __builtin_nontemporal_load((const u32x2*)(im + 512 * s1 + s20)); }
#pragma unroll
        for (int s1 = 0; s1 < N1; ++s1)
#pragma unroll
            for (int j = 0; j < 2; ++j) { zr[s1][2 * j] = bf_lo(a[s1][j]); zr[s1][2 * j + 1] = bf_hi(a[s1][j]); zi[s1][2 * j] = -bf_lo(b[s1][j]); zi[s1][2 * j + 1] = -bf_hi(b[s1][j]); }
    }
    DftK<N1, NP, 0>::run(zr, zi, tab, s20, scale, dst, k1stride);
}
__device__ void dft_stage1(const Params& p, unsigned char* shm) {
    const int tid = opaque_tid();
    float* tab = (float*)shm;
    for (int j = tid; j < 4096; j += 512) tab[TABI(j)] = cospif((float)j * (1.0f / 2048.0f));
    __syncthreads();
    const bf16_t* PTp = (const bf16_t*)((unsigned char*)p.out + OUT_PT); const bf16_t* PTs = (const bf16_t*)((unsigned char*)p.out + OUT_PTS);
    bf16_t* X1T = (bf16_t*)(p.ws + OFF_X1T);
#pragma unroll 1
    for (int it = blockIdx.x * 512 + tid; it < 16 * 512 * 64; it += gridDim.x * 512) {
        const int g = it & 63, col = (it >> 6) & 511, b = it >> 15;
        const bf16_t* re = PTp + (size_t)(b * 512 + col) * 4096;
        dft1_item<4, 8>(re, re + 2048, tab, g * 8, 0.02209708691207961f, X1T + (size_t)(b * 512 + col) * 1024 + g * 8, (size_t)16 * 512 * 1024);
    }
#pragma unroll 1
    for (int it = blockIdx.x * 512 + tid; it < 4 * 512 * 128; it += gridDim.x * 512) {
        const int g = it & 127, col = (it >> 7) & 511, b = it >> 16;
        const bf16_t* re = PTs + (size_t)(b * 512 + col) * 4096;
        dft1_item<8, 4>(re, re + (size_t)4 * 512 * 4096, tab, g * 4, 0.015625f, X1T + (size_t)(32768 + b * 512 + col) * 1024 + g * 4, (size_t)4 * 512 * 1024);
    }
}

struct SchedG2 {
    const char *YA, *YB, *WPA, *WPB; int G, c;
    __device__ __forceinline__ bool next(int i, Unit& u) const {
        const long L = (long)(i >> 1) * G + c; const int sub = i & 1;
        if (L >= 768) return false;
        int pm, pn; pg8::tile_map((int)L, 192, 4, pm, pn); u.pm = pm; u.pn = pn; u.kind = sub ? 0 : 1; u.pad = 0;
        u.A = (sub ? YB : YA) + (size_t)pm * 256 * 512 * 2; u.B = (sub ? WPB : WPA) + (size_t)pn * 256 * 512 * 2; return true;
    }
};
struct EpiG2 {
    static constexpr bool PERM = true, OWN_ACC = true;
    const bf16_t* ZR2; bf16_t* MG;
    __device__ __forceinline__ void operator()(f32x4 (&acc)[2][2][4][2], const Unit& u, int wr, int wc, int fr_, int fq_) const {
        int fr = fr_, fq = fq_; asm volatile("" : "+v"(fr), "+v"(fq));
        const int row0 = u.pm * 256 + wr * 64 + fr, col0 = u.pn * 256 + wc * 32 + 8 * fq;
        const bool keep = (u.kind & 1) != 0;
        const float kf = keep ? 1.f : 0.f;
        const int zoff = keep ? 0 : 1024;
        u32x4 bv[2][4][2];
#pragma unroll
        for (int ai = 0; ai < 2; ++ai)
#pragma unroll
            for (int m = 0; m < 4; ++m)
#pragma unroll
                for (int bj = 0; bj < 2; ++bj) bv[ai][m][bj] = __builtin_nontemporal_load((const u32x4*)(ZR2 + (size_t)(row0 + ai * 128 + m * 16) * 2048 + zoff + col0 + bj * 128));
#pragma unroll
        for (int ai = 0; ai < 2; ++ai) {
#pragma unroll
            for (int m = 0; m < 4; ++m) { const size_t row = (size_t)(row0 + ai * 128 + m * 16);
#pragma unroll
                for (int bj = 0; bj < 2; ++bj) { const u32x4 b = bv[ai][m][bj];
                    f32x4 v0 = acc[ai][bj][m][0], v1 = acc[ai][bj][m][1];
                    v0[0] *= bf_lo(b[0]); v0[1] *= bf_hi(b[0]); v0[2] *= bf_lo(b[1]); v0[3] *= bf_hi(b[1]);
                    v1[0] *= bf_lo(b[2]); v1[1] *= bf_hi(b[2]); v1[2] *= bf_lo(b[3]); v1[3] *= bf_hi(b[3]);
                    if (!keep) *(u32x4*)(MG + row * 1024 + col0 + bj * 128) = pack8(v0, v1);
                    acc[ai][bj][m][0] = v0 * kf; acc[ai][bj][m][1] = v1 * kf; } }
        }
    }
};

struct SchedG3 {
    const char *MG, *WOUT; int G, c;
    __device__ __forceinline__ bool next(int i, Unit& u) const {
        const int q = G >> 2, pn = c / q, pm = i * q + c % q;
        if (pm >= 192) return false;
        u.pm = pm; u.pn = pn; u.kind = 0; u.pad = 0;
        u.A = MG + (size_t)pm * 256 * 1024 * 2; u.B = WOUT + (size_t)pn * 256 * 1024 * 2; return true;
    }
};
typedef __attribute__((address_space(1))) unsigned long long gu64;
struct EpiG3 {     static constexpr bool OWN_ACC = false;
    static constexpr bool PERM = false;
    const float *x_p, *x_s, *GATE, *final_g; float* out; unsigned long long* GRN;
    __device__ __forceinline__ void operator()(f32x4 (&acc)[2][2][4][2], const Unit& u, int wr, int wc, int fr_, int fq_) const {
        int fr = fr_, fq = fq_; asm volatile("" : "+v"(fr), "+v"(fq));
        const int row0 = u.pm * 256 + wr * 64 + fr, col0 = u.pn * 256 + wc * 32 + 4 * fq;
        const int b = batch_of(u.pm * 256);
        float rs[2][4];
        {
            f32x4 gv[2][2];
#pragma unroll
            for (int bj = 0; bj < 2; ++bj)
#pragma unroll
                for (int n = 0; n < 2; ++n) gv[bj][n] = *(const f32x4*)(GATE + b * 1024 + col0 + bj * 128 + n * 16);
#pragma unroll
            for (int ai = 0; ai < 2; ++ai)
#pragma unroll
                for (int m = 0; m < 4; ++m) { const int row = row0 + ai * 128 + m * 16;
                    const float* xr = (row < NTOK_P ? x_p + (size_t)row * D : x_s + (size_t)(row - NTOK_P) * D) + col0;
                    float ss = 0.f;
#pragma unroll
                    for (int bj = 0; bj < 2; ++bj)
#pragma unroll
                        for (int n = 0; n < 2; ++n) { const f32x4 xv = __builtin_nontemporal_load((const f32x4*)(xr + bj * 128 + n * 16));
                            const f32x4 y = xv + gv[bj][n] * acc[ai][bj][m][n]; acc[ai][bj][m][n] = y;
                            ss += y[0] * y[0] + y[1] * y[1] + y[2] * y[2] + y[3] * y[3]; }
                    ss += __shfl_xor(ss, 16, 64); ss += __shfl_xor(ss, 32, 64);
                    rs[ai][m] = ss; }
        }
        float w0 = 0.f, w1 = 0.f;
#pragma unroll
        for (int jj = 0; jj < 8; ++jj) { if ((jj >> 1) == fq) { if (jj & 1) w1 = rs[jj >> 2][jj & 3]; else w0 = rs[jj >> 2][jj & 3]; } }
        const int jj0 = 2 * fq, jj1 = 2 * fq + 1;
        const int lr0 = (jj0 >> 2) * 128 + wr * 64 + (jj0 & 3) * 16 + fr, lr1 = (jj1 >> 2) * 128 + wr * 64 + (jj1 & 3) * 16 + fr;
        gu64* gp = (gu64*)GRN + (size_t)u.pm * (4 * 4 * 256);
        __hip_atomic_store(gp + ((u.pn * 4 + wc) * 256 + lr0), (1ull << 32) | (unsigned long long)__float_as_uint(w0), __ATOMIC_RELAXED, __HIP_MEMORY_SCOPE_AGENT);
        __hip_atomic_store(gp + ((u.pn * 4 + wc) * 256 + lr1), (1ull << 32) | (unsigned long long)__float_as_uint(w1), __ATOMIC_RELAXED, __HIP_MEMORY_SCOPE_AGENT);
        float t0 = 0.f, t1 = 0.f;
        for (unsigned spins = 0;; ++spins) {
            bool ok = true; t0 = 0.f; t1 = 0.f;
#pragma unroll 4
            for (int k = 0; k < 16; ++k) {
                const unsigned long long a = __hip_atomic_load(gp + (k * 256 + lr0), __ATOMIC_RELAXED, __HIP_MEMORY_SCOPE_AGENT);
                const unsigned long long c = __hip_atomic_load(gp + (k * 256 + lr1), __ATOMIC_RELAXED, __HIP_MEMORY_SCOPE_AGENT);
                ok &= ((a >> 32) == 1ull) & ((c >> 32) == 1ull);
                t0 += __uint_as_float((unsigned)a); t1 += __uint_as_float((unsigned)c); }
            if (__all(ok) || spins > (1u << 20)) break;
            __builtin_amdgcn_s_sleep(4);
        }
        const float ri0 = rsqrtf(t0 * (1.0f / 1024.0f) + 1e-6f), ri1 = rsqrtf(t1 * (1.0f / 1024.0f) + 1e-6f);
        f32x4 fg[2][2];
#pragma unroll
        for (int bj = 0; bj < 2; ++bj)
#pragma unroll
            for (int n = 0; n < 2; ++n) fg[bj][n] = *(const f32x4*)(final_g + col0 + bj * 128 + n * 16);
#pragma unroll
        for (int ai = 0; ai < 2; ++ai)
#pragma unroll
            for (int m = 0; m < 4; ++m) { const int jj = ai * 4 + m; const int row = row0 + ai * 128 + m * 16;
                const float rinv = __shfl((jj & 1) ? ri1 : ri0, fr + 16 * (jj >> 1), 64);
                float* orow = out + (size_t)row * D + col0;
#pragma unroll
                for (int bj = 0; bj < 2; ++bj)
#pragma unroll
                    for (int n = 0; n < 2; ++n) *(f32x4*)(orow + bj * 128 + n * 16) = acc[ai][bj][m][n] * rinv * fg[bj][n]; }
    }
};

__device__ __forceinline__ int win_dstrow(int src) {
    if (src < 1024) return src + 1024;
    if (src < 1536) { const int m = src - 1024; return 2048 + (m >> 7) * 256 + (m & 127); }
    if (src < 2048) return src - 512;
    if (src < 2560) { const int m = src - 2048; return 2048 + (m >> 7) * 256 + 128 + (m & 127); }
    if (src < 3584) { const int m = src - 2560; return 3072 + (m >> 7) * 256 + (m & 127); }
    const int m = src - 3584; return 3072 + (m >> 7) * 256 + 128 + (m & 127);
}
template <bool WIN> __device__ __forceinline__ void transpose_item(const float* src, int src_pitch, int r0, int c0, bf16_t* dst, int dst_row0, int dst_pitch, float* tl, int tid) {
    f32x4 v[8];
#pragma unroll
    for (int i = 0; i < 8; ++i) { const int idx = i * 512 + tid, rr = idx >> 6, c4 = idx & 63; v[i] = __builtin_nontemporal_load((const f32x4*)(src + (size_t)(r0 + rr) * src_pitch + c0 + c4 * 4)); }
#pragma unroll
    for (int i = 0; i < 8; ++i) { const int idx = i * 512 + tid, rr = idx >> 6, c4 = idx & 63;
        *(f32x4*)(tl + rr * 260 + c4 * 4) = v[i]; }
    __syncthreads();
    const int cc = tid >> 1, half = tid & 1;
    const int drow = WIN ? win_dstrow(c0 + cc) : dst_row0 + cc;
    bf16_t* d = dst + (size_t)drow * dst_pitch + r0 + half * 32;
#pragma unroll
    for (int q = 0; q < 4; ++q) { u32x4 o;
#pragma unroll
        for (int i = 0; i < 4; ++i) o[i] = cvt_pk_bf16(tl[(half * 32 + q * 8 + 2 * i) * 260 + cc], tl[(half * 32 + q * 8 + 2 * i + 1) * 260 + cc]);
        *(u32x4*)(d + q * 8) = o; }
}

__device__ void phase0(const Params& p, unsigned char* shm) {
    const int tid0 = opaque_tid();
    float* tab = (float*)shm;
    float* scr = (float*)(shm + 17408);
    unsigned char* ws = p.ws;
    for (int j = tid0; j < 4096; j += 512) tab[TABI(j)] = cospif((float)j * (1.0f / 2048.0f));
    { unsigned long long* grn = (unsigned long long*)(p.ws + OFF_GRN);
      for (size_t i = (size_t)blockIdx.x * 512 + tid0; i < GRN_WORDS; i += (size_t)gridDim.x * 512) grn[i] = 0ull; }
    __syncthreads();
    constexpr int I_MOD = 384, I_TIN = I_MOD + 256, I_TPA = I_TIN + 32, I_TPB = I_TPA + 32, I_TOUT = I_TPB + 64, I_FOLD = I_TOUT + 256, I_WS = I_FOLD + 8, I_DFT = I_WS + 128;
    for (int item = blockIdx.x; item < I_DFT; item += gridDim.x) {
        int tid = tid0; asm volatile("" : "+v"(tid));
        const int w = tid >> 6, lane = tid & 63;
        if (item < I_MOD) {
            const int jt = item % 48, kc = item / 48;
            float* sc = scr; float* red = scr + 2560;
            const int j = jt * 64 + lane;
            float wv[16], cv[5];
#pragma unroll
            for (int kk = 0; kk < 16; ++kk) wv[kk] = __builtin_nontemporal_load(p.w_ada + (size_t)(kc * 128 + w * 16 + kk) * 3072 + j);
#pragma unroll
            for (int i = 0; i < 5; ++i) { const int idx = tid + i * 512, b = idx >> 7, k = kc * 128 + (idx & 127); cv[i] = b < 16 ? p.c_p[b * 1024 + k] : p.c_s[(b - 16) * 1024 + k]; }
#pragma unroll
            for (int i = 0; i < 5; ++i) sc[tid + i * 512] = silu(cv[i]);
            __syncthreads();
            float acc[NB];
#pragma unroll
            for (int b = 0; b < NB; ++b) acc[b] = 0.f;
#pragma unroll
            for (int kk = 0; kk < 16; ++kk) { const int kl = w * 16 + kk;
#pragma unroll
                for (int b = 0; b < NB; ++b) acc[b] += sc[b * 128 + kl] * wv[kk]; }
#pragma unroll
            for (int b = 0; b < NB; ++b) red[(w * NB + b) * 64 + lane] = acc[b];
            __syncthreads();
            for (int idx = tid; idx < NB * 64; idx += 512) { const int b = idx >> 6, l = idx & 63; float s = 0.f;
#pragma unroll
                for (int ww = 0; ww < 8; ++ww) s += red[(ww * NB + b) * 64 + l];
                const int jj = jt * 64 + l; if (kc == 0) s += p.b_ada[jj];
                ((float*)(ws + OFF_MODP))[(size_t)(kc * NB + b) * 3072 + jj] = s; }
        } else if (item < I_TIN) {
            const int it = item - I_MOD, rt = it & 15, ct = it >> 4;
            transpose_item<true>(p.w_in, INW, rt * 64, 512 + ct * 256, (bf16_t*)(ws + OFF_WT1), 0, 1024, scr, tid);
        } else if (item < I_TPA) {
            const int it = item - I_TIN, rt = it & 7, ct = it >> 3;
            transpose_item<false>(p.w_pa, 1024, rt * 64, ct * 256, (bf16_t*)(ws + OFF_WPA), ct * 256, 512, scr, tid);
        } else if (item < I_TPB) {
            const int it = item - I_TPA, rt = it & 7, ct = it >> 3;
            transpose_item<false>(p.w_pb, 1024, rt * 64, ct * 256, (bf16_t*)(ws + OFF_WPB), ct * 256, 512, scr, tid);
        } else if (item < I_TOUT) {
            const int it = item - I_TPB, rt = it & 15, ct = it >> 4;
            transpose_item<false>(p.w_out, 1024, rt * 64, ct * 256, (bf16_t*)(ws + OFF_WOUT), ct * 256, 1024, scr, tid);
        } else if (item < I_FOLD) {
            const int it = item - I_TOUT, dt = it & 31, pg = it >> 5, part = pg >> 2, g = pg & 3, d0 = dt * 32;
            float* wt = scr; float* U = scr + 4096;
            { const int rr = tid >> 4, cc = (tid & 15) * 8; const float* s = p.w_in + (size_t)(d0 + rr) * INW + g * 128 + cc;
              const f32x4 a = __builtin_nontemporal_load((const f32x4*)s), b = __builtin_nontemporal_load((const f32x4*)(s + 4));
#pragma unroll
              for (int i = 0; i < 4; ++i) { wt[rr * 128 + cc + i] = a[i]; wt[rr * 128 + cc + 4 + i] = b[i]; } }
            __syncthreads();
            const int m = tid & 127, ddg = tid >> 7;
            float acc[8];
#pragma unroll
            for (int i = 0; i < 8; ++i) acc[i] = 0.f;
#pragma unroll 2
            for (int c = 0; c < 128; c += 4) { f32x4 tv;
#pragma unroll
                for (int k = 0; k < 4; ++k) { const int idx = (((c + k) * m) & 127) * 32; tv[k] = part ? tab[TABI((idx - 1024) & 4095)] : tab[TABI(idx)]; }
#pragma unroll
                for (int i = 0; i < 8; ++i) { const f32x4 wv = *(const f32x4*)(wt + (ddg * 8 + i) * 128 + c); acc[i] += wv[0] * tv[0] + wv[1] * tv[1] + wv[2] * tv[2] + wv[3] * tv[3]; } }
#pragma unroll
            for (int i = 0; i < 8; ++i) U[(ddg * 8 + i) * 128 + m] = acc[i];
            __syncthreads();
#pragma unroll
            for (int i = 0; i < 8; ++i) acc[i] = 0.f;
#pragma unroll 2
            for (int mm = 0; mm < 128; mm += 4) { f32x4 fv;
#pragma unroll
                for (int k = 0; k < 4; ++k) fv[k] = p.w_fmix[(size_t)(g * 128 + mm + k) * 128 + m];
#pragma unroll
                for (int i = 0; i < 8; ++i) { const f32x4 uv = *(const f32x4*)(U + (ddg * 8 + i) * 128 + mm); acc[i] += uv[0] * fv[0] + uv[1] * fv[1] + uv[2] * fv[2] + uv[3] * fv[3]; } }
            const float sc = 0.08838834764831845f;
            u32x4 o;
#pragma unroll
            for (int i = 0; i < 4; ++i) o[i] = cvt_pk_bf16(acc[2 * i] * sc, acc[2 * i + 1] * sc);
            *(u32x4*)((bf16_t*)(ws + OFF_WT1) + (size_t)(part * 512 + g * 128 + m) * 1024 + d0 + ddg * 8) = o;
        } else if (item < I_WS) {
            const int it = item - I_FOLD; const size_t e = (size_t)it * 8192 + tid * 16; const float* s = p.w_s + e;
            const f32x4 a = *(const f32x4*)s, b = *(const f32x4*)(s + 4), c = *(const f32x4*)(s + 8), d = *(const f32x4*)(s + 12);
            bf16_t* dst = (bf16_t*)(ws + OFF_WSS) + e;
            *(u32x4*)dst = pack8(a, b); *(u32x4*)(dst + 8) = pack8(c, d);
        } else {
            const int r = item - I_WS, k2 = r * 4 + (tid >> 7), e0 = (tid & 127) * 8, part = e0 >> 9;
            float v[8]; bf16_t* dst = (bf16_t*)(ws + OFF_D2) + (size_t)k2 * 1024 + e0;
#pragma unroll
            for (int i = 0; i < 8; ++i) { const int s2 = (e0 + i) & 511, j8 = ((k2 * s2) & 511) * 8; v[i] = part ? tab[TABI((j8 - 1024) & 4095)] : tab[TABI(j8)]; }
            u32x4 o;
#pragma unroll
            for (int i = 0; i < 4; ++i) o[i] = cvt_pk_bf16(v[2 * i], v[2 * i + 1]);
            *(u32x4*)dst = o;
        }
        __syncthreads();
    }
}

__device__ void phase1(const Params& p, unsigned char* shm) {
    const int tid = opaque_tid(), w = tid >> 6, lane = tid & 63;
    float* cA = (float*)shm; float* cB = cA + 1024;
    const float* MODP = (const float*)(p.ws + OFF_MODP); float* GATE = (float*)(p.ws + OFF_GATE);
    bf16_t* H = (bf16_t*)((unsigned char*)p.out + OUT_H);
    for (int b = blockIdx.x; b < NB; b += gridDim.x)
        for (int n = tid; n < 1024; n += 512) { float s = 0.f;
#pragma unroll
            for (int kc = 0; kc < 8; ++kc) s += MODP[(size_t)(kc * NB + b) * 3072 + 2048 + n];
            GATE[b * 1024 + n] = s; }
    for (int g = blockIdx.x; g < NTOK / 64; g += gridDim.x) {
        const int token0 = g * 64, b = batch_of(token0);
        __syncthreads();
        for (int d = tid; d < 1024; d += 512) { float sh = 0.f, sc = 0.f;
#pragma unroll
            for (int kc = 0; kc < 8; ++kc) { sh += MODP[(size_t)(kc * NB + b) * 3072 + d]; sc += MODP[(size_t)(kc * NB + b) * 3072 + 1024 + d]; }
            cA[d] = p.norm_g[d] * (1.f + sc); cB[d] = sh; }
        __syncthreads();
        const f32x4 a0 = *(const f32x4*)(cA + lane * 8), a1 = *(const f32x4*)(cA + lane * 8 + 4), a2 = *(const f32x4*)(cA + 512 + lane * 8), a3 = *(const f32x4*)(cA + 512 + lane * 8 + 4);
        const f32x4 b0 = *(const f32x4*)(cB + lane * 8), b1 = *(const f32x4*)(cB + lane * 8 + 4), b2 = *(const f32x4*)(cB + 512 + lane * 8), b3 = *(const f32x4*)(cB + 512 + lane * 8 + 4);
#pragma unroll 1
        for (int r4 = 0; r4 < 8; r4 += 4) {
            f32x4 v[4][4];
#pragma unroll
            for (int j = 0; j < 4; ++j) { const float* xr = xrow(p, token0 + w * 8 + r4 + j);
                v[j][0] = __builtin_nontemporal_load((const f32x4*)(xr + lane * 8)); v[j][1] = __builtin_nontemporal_load((const f32x4*)(xr + lane * 8 + 4)); v[j][2] = __builtin_nontemporal_load((const f32x4*)(xr + 512 + lane * 8)); v[j][3] = __builtin_nontemporal_load((const f32x4*)(xr + 512 + lane * 8 + 4)); }
#pragma unroll
            for (int j = 0; j < 4; ++j) {
                float ss = 0.f;
#pragma unroll
                for (int i = 0; i < 4; ++i) ss += v[j][0][i] * v[j][0][i] + v[j][1][i] * v[j][1][i] + v[j][2][i] * v[j][2][i] + v[j][3][i] * v[j][3][i];
                ss = wave_sum(ss);
                const float rinv = rsqrtf(ss * (1.0f / 1024.0f) + 1e-6f);
                bf16_t* hr = H + (size_t)(token0 + w * 8 + r4 + j) * 1024;
                *(u32x4*)(hr + lane * 8) = pack8(v[j][0] * rinv * a0 + b0, v[j][1] * rinv * a1 + b1);
                *(u32x4*)(hr + 512 + lane * 8) = pack8(v[j][2] * rinv * a2 + b2, v[j][3] * rinv * a3 + b3);
            }
        }
    }
}

__device__ __forceinline__ int sgu_swz(int c) { return ((c & 3) << 2) | ((c >> 4) & 3); }
__device__ void sgu_chunk(const Params& p, unsigned char* shm, int chunk) {
    const int tid = opaque_tid(), w = tid >> 6, lane = tid & 63;
    const bf16_t* ZR1 = (const bf16_t*)(p.ws + OFF_ZR1);
    const bf16_t* VT = (const bf16_t*)(p.ws + OFF_VT);
    const bf16_t* WSS = (const bf16_t*)(p.ws + OFF_WSS);
    bf16_t* YB = (bf16_t*)((unsigned char*)p.out + OUT_YB);
    float* st = (float*)(shm + 131072);
    float* mr = st + 1024;
    const int t0 = chunk * 128;
    {
        u32x4 raw[16];
#pragma unroll
        for (int it = 0; it < 16; ++it) { const int idx = it * 512 + tid, c = idx >> 4, g = idx & 15; raw[it] = __builtin_nontemporal_load((const u32x4*)(VT + (size_t)c * NTOK + t0 + g * 8)); }
#pragma unroll
        for (int it = 0; it < 16; ++it) { const int idx = it * 512 + tid, c = idx >> 4, g = idx & 15; *(u32x4*)(shm + c * 256 + ((g ^ sgu_swz(c)) << 4)) = raw[it]; }
    }
    const float lg = p.ln_g[tid], lb = p.ln_b[tid];
    const int h = w >> 1, c0 = h * 128 + (w & 1) * 64, fr = lane & 15, fq = lane >> 4;
    u32x4 uu[4][2][2];
#pragma unroll
    for (int ph = 0; ph < 4; ++ph)
#pragma unroll
        for (int pt = 0; pt < 2; ++pt) { const size_t token = (size_t)t0 + ph * 32 + pt * 16 + fr; const bf16_t* zr = ZR1 + token * 1024 + 512 + c0 + fq * 16;
            uu[ph][pt][0] = __builtin_nontemporal_load((const u32x4*)zr); uu[ph][pt][1] = __builtin_nontemporal_load((const u32x4*)(zr + 8)); }
    __syncthreads();
    {
        const int q = tid & 127, qr = tid >> 7;
        float s = 0.f, ss = 0.f;
#pragma unroll 8
        for (int cc = 0; cc < 128; ++cc) { const int c = qr * 128 + cc;
            const float v = __uint_as_float((unsigned)(*(const bf16_t*)(shm + c * 256 + ((((q >> 3) ^ sgu_swz(c)) << 4) | ((q & 7) * 2)))) << 16);
            s += v; ss += v * v; }
        st[(qr * 128 + q) * 2] = s; st[(qr * 128 + q) * 2 + 1] = ss;
    }
    __syncthreads();
    if (tid < 128) { float s = 0.f, ss = 0.f;
#pragma unroll
        for (int qr = 0; qr < 4; ++qr) { s += st[(qr * 128 + tid) * 2]; ss += st[(qr * 128 + tid) * 2 + 1]; }
        const float mean = s * (1.0f / 512.0f); float var = ss * (1.0f / 512.0f) - mean * mean; var = var < 0.f ? 0.f : var;
        mr[tid] = mean; mr[128 + tid] = rsqrtf(var + 1e-6f); }
    __syncthreads();
    st[tid] = lg; st[512 + tid] = lb;
    __syncthreads();
#pragma unroll 4
    for (int it = 0; it < 16; ++it) { const int idx = it * 512 + tid, c = idx >> 4, g = idx & 15;
        unsigned char* ap = shm + c * 256 + ((g ^ sgu_swz(c)) << 4);
        const u32x4 raw = *(const u32x4*)ap;
        const float gam = st[c], bet = st[512 + c];
        const f32x4 m0 = *(const f32x4*)(mr + g * 8), m1 = *(const f32x4*)(mr + g * 8 + 4), r0 = *(const f32x4*)(mr + 128 + g * 8), r1 = *(const f32x4*)(mr + 128 + g * 8 + 4);
        u32x4 o;
        o[0] = cvt_pk_bf16((bf_lo(raw[0]) - m0[0]) * r0[0] * gam + bet, (bf_hi(raw[0]) - m0[1]) * r0[1] * gam + bet);
        o[1] = cvt_pk_bf16((bf_lo(raw[1]) - m0[2]) * r0[2] * gam + bet, (bf_hi(raw[1]) - m0[3]) * r0[3] * gam + bet);
        o[2] = cvt_pk_bf16((bf_lo(raw[2]) - m1[0]) * r1[0] * gam + bet, (bf_hi(raw[2]) - m1[1]) * r1[1] * gam + bet);
        o[3] = cvt_pk_bf16((bf_lo(raw[3]) - m1[2]) * r1[2] * gam + bet, (bf_hi(raw[3]) - m1[3]) * r1[3] * gam + bet);
        *(u32x4*)ap = o; }
    __syncthreads();
    {
        const int arow = c0 + (fr >> 2) * 16 + (fr & 3);
        bf16x8 b[2][4][2];
#pragma unroll
        for (int kk = 0; kk < 4; ++kk)
#pragma unroll
            for (int pt = 0; pt < 2; ++pt) b[0][kk][pt] = *(const bf16x8*)(WSS + (size_t)(h * 128 + pt * 16 + fr) * 128 + kk * 32 + fq * 8);
#pragma unroll
        for (int ph = 0; ph < 4; ++ph) {
            if (ph < 3) {
#pragma unroll
                for (int kk = 0; kk < 4; ++kk)
#pragma unroll
                    for (int pt = 0; pt < 2; ++pt) b[(ph + 1) & 1][kk][pt] = *(const bf16x8*)(WSS + (size_t)(h * 128 + (ph + 1) * 32 + pt * 16 + fr) * 128 + kk * 32 + fq * 8);
            }
            f32x4 acc[4][2];
#pragma unroll
            for (int ct = 0; ct < 4; ++ct)
#pragma unroll
                for (int pt = 0; pt < 2; ++pt) acc[ct][pt] = (f32x4){0.f, 0.f, 0.f, 0.f};
#pragma unroll
            for (int kk = 0; kk < 4; ++kk) {
                bf16x8 a[4];
#pragma unroll
                for (int ct = 0; ct < 4; ++ct) { const int row = arow + ct * 4; a[ct] = *(const bf16x8*)(shm + row * 256 + (((kk * 4 + fq) ^ sgu_swz(row)) << 4)); }
#pragma unroll
                for (int ct = 0; ct < 4; ++ct)
#pragma unroll
                    for (int pt = 0; pt < 2; ++pt) acc[ct][pt] = __builtin_amdgcn_mfma_f32_16x16x32_bf16(a[ct], b[ph & 1][kk][pt], acc[ct][pt], 0, 0, 0);
            }
#pragma unroll
            for (int pt = 0; pt < 2; ++pt) {
                const int pp = ph * 32 + pt * 16 + fr; const size_t token = (size_t)t0 + pp; const float bias = p.b_s[h * 128 + pp];
                u32x4 o[2];
#pragma unroll
                for (int hh = 0; hh < 2; ++hh)
#pragma unroll
                    for (int k2 = 0; k2 < 4; ++k2) {
                        const int ct = 2 * hh + (k2 >> 1), j = 2 * (k2 & 1);
                        const unsigned uw = uu[ph][pt][hh][k2];
                        const float o0 = (acc[ct][pt][j] + bias) * bf_lo(uw);
                        const float o1 = (acc[ct][pt][j + 1] + bias) * bf_hi(uw);
                        o[hh][k2] = cvt_pk_bf16(o0, o1); }
                bf16_t* yp = YB + token * 512 + c0 + fq * 16;
                *(u32x4*)yp = o[0]; *(u32x4*)(yp + 8) = o[1];
            }
        }
    }
    __syncthreads();
}

#define XB_TMO      128
#define XB_XCNT(j)  (256  + 64 * (j))
#define XB_XSUB(j)  (1280 + 64 * (j))
#define XB_XGEN(j)  (2304 + 64 * (j))
#define XB_TOP      3328
#define XB_TOPGEN   3392
#define XB_SPIN_CAP (1u << 18)
__device__ __forceinline__ unsigned xb_ld(unsigned* p)              { return __hip_atomic_load(p, __ATOMIC_RELAXED, __HIP_MEMORY_SCOPE_AGENT); }
__device__ __forceinline__ unsigned xb_add(unsigned* p, unsigned v) { return __hip_atomic_fetch_add(p, v, __ATOMIC_RELAXED, __HIP_MEMORY_SCOPE_AGENT); }
__device__ __forceinline__ unsigned xb_xcc_id() { return (unsigned)__builtin_amdgcn_s_getreg((3 << 11) | 20) & 0xFu; }
#define XB_SPIN(cond, bar) do { unsigned _sp = 0; while (cond) { __builtin_amdgcn_s_sleep(1); \
    if ((++_sp & 255u) == 0u) { if (xb_ld(&(bar)[XB_TMO])) break; if (_sp > XB_SPIN_CAP) { atomicAdd(&(bar)[XB_TMO], 1u); break; } } } } while (0)
struct XcdBarrier { unsigned* bar; unsigned x; volatile LAS unsigned* st; };
__device__ __forceinline__ XcdBarrier xcd_barrier_post(unsigned* bar, volatile LAS unsigned* st) {
    XcdBarrier b; b.bar = bar; b.x = xb_xcc_id(); b.st = st;
    if (threadIdx.x == 0) (void)xb_add(&bar[XB_XCNT(b.x)], 1u);
    return b;
}
__device__ __forceinline__ void xcd_barrier_complete(unsigned* bar, unsigned x, unsigned& nloc, unsigned& nx) {
    const unsigned G = gridDim.x * gridDim.y * gridDim.z;
    unsigned sum, cnt, mine, sp = 0u;
    for (;;) {
        sum = 0u; cnt = 0u; mine = 0u;
#pragma unroll
        for (unsigned j = 0; j < 16; ++j) { const unsigned c = xb_ld(&bar[XB_XCNT(j)]); sum += c; cnt += (c > 0u) ? 1u : 0u; mine = (j == x) ? c : mine; }
        if (sum == G) break;
        __builtin_amdgcn_s_sleep(1);
        if ((++sp & 255u) == 0u) { if (xb_ld(&bar[XB_TMO])) break; if (sp > XB_SPIN_CAP) { atomicAdd(&bar[XB_TMO], 1u); break; } }
    }
    nloc = mine > 0u ? mine : 1u; nx = cnt > 0u ? cnt : 1u;
}
__device__ __forceinline__ void xcd_barrier(const XcdBarrier& b) {
    asm volatile("s_waitcnt vmcnt(0)" ::: "memory");
    __syncthreads();
    if (threadIdx.x == 0) {
        unsigned* bar = b.bar;
        __builtin_amdgcn_s_waitcnt(0);
        unsigned nloc = b.st[0], nx = b.st[1];
        if (nloc == 0u) { xcd_barrier_complete(bar, b.x, nloc, nx); b.st[0] = nloc; b.st[1] = nx; }
        const unsigned old = xb_add(&bar[XB_XSUB(b.x)], 1u);
        const unsigned gen = old / nloc;
        if (old + 1u == (gen + 1u) * nloc) {
            __builtin_amdgcn_fence(__ATOMIC_RELEASE, "agent");
            asm volatile("s_waitcnt vmcnt(0)" ::: "memory");
            const unsigned og = xb_add(&bar[XB_TOP], 1u);
            const unsigned tg = og / nx;
            if (og + 1u == (tg + 1u) * nx) xb_add(&bar[XB_TOPGEN], 1u);
            else XB_SPIN(xb_ld(&bar[XB_TOPGEN]) == tg, bar);
            __builtin_amdgcn_fence(__ATOMIC_ACQUIRE, "agent");
            xb_add(&bar[XB_XGEN(b.x)], 1u);
            asm volatile("s_waitcnt vmcnt(0)" ::: "memory");
        } else {
            XB_SPIN(xb_ld(&bar[XB_XGEN(b.x)]) == gen, bar);
            __builtin_amdgcn_fence(__ATOMIC_ACQUIRE, "agent");
            asm volatile("s_waitcnt vmcnt(0)" ::: "memory");
        }
    }
    __syncthreads();
}

__global__ void __launch_bounds__(512, 2) fwd_megakernel(Params p) {
    extern __shared__ __attribute__((aligned(16))) unsigned char shm[];
    cg::grid_group grid = cg::this_grid();
    LAS unsigned char* lds = (LAS unsigned char*)shm;
    unsigned char* ws = p.ws; unsigned char* ob = (unsigned char*)p.out;
    const int G = gridDim.x, c = blockIdx.x;
    volatile LAS unsigned* bst = (volatile LAS unsigned*)(lds + LDS_BYTES - 16);
    if (threadIdx.x == 0) { bst[0] = 0u; bst[1] = 0u; }
    __syncthreads();
    const XcdBarrier xb = xcd_barrier_post((unsigned*)(ws + OFF_BAR), bst);
    if (p.ws == nullptr) grid.sync();
    const int vc = (G % 8 == 0) ? (c % 8) * (G / 8) + c / 8 : c;

    phase0(p, shm);
    xcd_barrier(xb);
    phase1(p, shm);
    xcd_barrier(xb);
    {
        SchedG1 S; S.H = (const char*)(ob + OUT_H); S.WT1 = (const char*)(ws + OFF_WT1); S.G = G; S.c = c;
        EpiG1 E; E.ZR1 = (bf16_t*)(ws + OFF_ZR1); E.ZR2 = (bf16_t*)(ws + OFF_ZR2); E.PTp = (bf16_t*)(ob + OUT_PT); E.PTs = (bf16_t*)(ob + OUT_PTS); E.VT = (bf16_t*)(ws + OFF_VT);
        pg8::gemm_phase<EpiG1, SchedG1>(lds, 1024, S, E);
    }
    xcd_barrier(xb);
    dft_stage1(p, shm);
    xcd_barrier(xb);
    {
        SchedD2 S; S.D2 = (const char*)(ws + OFF_D2); S.X1T = (const char*)(ws + OFF_X1T); S.G = G; S.c = c;
        EpiD2 E; E.ZR1 = (const bf16_t*)(ws + OFF_ZR1); E.YA = (bf16_t*)(ob + OUT_YA); E.b_fmix = p.b_fmix;
        pg8::gemm_phase<EpiD2, SchedD2>(lds, 1024, S, E);
        __syncthreads();
        if (c < 128) sgu_chunk(p, shm, c);
        else for (int j = 0; j < 2; ++j) sgu_chunk(p, shm, 128 + (c - 128) * 2 + j);
    }
    xcd_barrier(xb);
    {
        SchedG2 S; S.YA = (const char*)(ob + OUT_YA); S.YB = (const char*)(ob + OUT_YB); S.WPA = (const char*)(ws + OFF_WPA); S.WPB = (const char*)(ws + OFF_WPB); S.G = G; S.c = c;
        EpiG2 E; E.ZR2 = (const bf16_t*)(ws + OFF_ZR2); E.MG = (bf16_t*)(ws + OFF_ZR1);
        pg8::gemm_phase<EpiG2, SchedG2>(lds, 512, S, E);
    }
    xcd_barrier(xb);
    {
        SchedG3 S; S.MG = (const char*)(ws + OFF_ZR1); S.WOUT = (const char*)(ws + OFF_WOUT); S.G = G; S.c = c;
        EpiG3 E; E.x_p = p.x_p; E.x_s = p.x_s; E.GATE = (const float*)(ws + OFF_GATE); E.final_g = p.final_g; E.out = p.out; E.GRN = (unsigned long long*)(ws + OFF_GRN);
        pg8::gemm_phase<EpiG3, SchedG3>(lds, 1024, S, E);
    }
}

extern "C" void kernel_launch(void* const* d_in, const int* in_sizes, int n_in, void* d_out, int out_size, void* d_ws, size_t ws_size, hipStream_t stream) {
    static int grid = 0;
    if (grid == 0) {
        if (n_in != 18 || out_size != NTOK * D || ws_size < WS_END) { fprintf(stderr, "kernel_launch: unexpected shapes (n_in %d out %d ws %zu need %zu)\n", n_in, out_size, ws_size, (size_t)WS_END); grid = -1; return; }
        int dev = 0, cus = 0, per_cu = 0;
        hipGetDevice(&dev);
        hipDeviceGetAttribute(&cus, hipDeviceAttributeMultiprocessorCount, dev);
        if (hipFuncSetAttribute((const void*)fwd_megakernel, hipFuncAttributeMaxDynamicSharedMemorySize, LDS_BYTES) != hipSuccess) { fprintf(stderr, "kernel_launch: hipFuncSetAttribute failed\n"); grid = -1; return; }
        if (hipOccupancyMaxActiveBlocksPerMultiprocessor(&per_cu, (const void*)fwd_megakernel, 512, LDS_BYTES) != hipSuccess || per_cu < 1) { fprintf(stderr, "kernel_launch: occupancy query gave %d\n", per_cu); per_cu = 1; }
        (void)hipGetLastError();
        grid = cus * per_cu;
        if (grid != 256) { fprintf(stderr, "kernel_launch: this build needs a 256-workgroup cooperative grid, got %d\n", grid); grid = -1; return; }
        fprintf(stderr, "kernel_launch: grid %d (cus %d x %d)\n", grid, cus, per_cu);
    }
    if (grid < 0) return;
    Params p{};
    p.x_p = (const float*)d_in[0]; p.x_s = (const float*)d_in[1]; p.c_p = (const float*)d_in[2]; p.c_s = (const float*)d_in[3];
    p.norm_g = (const float*)d_in[4]; p.w_ada = (const float*)d_in[5]; p.b_ada = (const float*)d_in[6]; p.w_in = (const float*)d_in[7];
    p.w_fmix = (const float*)d_in[8]; p.b_fmix = (const float*)d_in[9]; p.ln_g = (const float*)d_in[10]; p.ln_b = (const float*)d_in[11];
    p.w_s = (const float*)d_in[12]; p.b_s = (const float*)d_in[13]; p.w_pa = (const float*)d_in[14]; p.w_pb = (const float*)d_in[15];
    p.w_out = (const float*)d_in[16]; p.final_g = (const float*)d_in[17];
    p.out = (float*)d_out; p.ws = (unsigned char*)d_ws;
    if (hipMemsetAsync((unsigned char*)d_ws + OFF_BAR, 0, BAR_BYTES, stream) != hipSuccess) { fprintf(stderr, "kernel_launch: memset of the barrier words failed\n"); return; }
    void* args[] = {&p};
    hipError_t e = hipLaunchCooperativeKernel((const void*)fwd_megakernel, dim3(grid), dim3(512), args, LDS_BYTES, stream);
    if (e != hipSuccess) fprintf(stderr, "kernel_launch: cooperative launch failed: %s (grid %d)\n", hipGetErrorString(e), grid);
}
```

```cpp
#include <hip/hip_runtime.h>
#include <hip/hip_cooperative_groups.h>
#include <cstdio>
namespace cg = cooperative_groups;

#define LAS __attribute__((address_space(3)))
typedef unsigned short bf16_t;
typedef short bf16x8 __attribute__((ext_vector_type(8)));
typedef float f32x4 __attribute__((ext_vector_type(4)));
typedef unsigned u32x4 __attribute__((ext_vector_type(4)));
typedef unsigned u32x2 __attribute__((ext_vector_type(2)));

constexpr int D = 1024;
constexpr int NTOK = 49152, NTOK_P = 32768;
constexpr int SP = 2048, SS = 4096;
constexpr int NB = 20;
constexpr int INW = 4608;
constexpr int LDS_BYTES = 131072 + 8192;

constexpr size_t OFF_MODP = 0;
constexpr size_t OFF_GATE = OFF_MODP + (size_t)8 * 20 * 3072 * 4;
constexpr size_t OFF_WT1  = OFF_GATE + (size_t)20 * 1024 * 4;
constexpr size_t OFF_WPA  = OFF_WT1 + (size_t)5120 * 1024 * 2;
constexpr size_t OFF_WPB  = OFF_WPA + (size_t)1024 * 512 * 2;
constexpr size_t OFF_WOUT = OFF_WPB + (size_t)1024 * 512 * 2;
constexpr size_t OFF_WSS  = OFF_WOUT + (size_t)1024 * 1024 * 2;
constexpr size_t OFF_D2   = OFF_WSS + (size_t)4 * 128 * 128 * 2;
constexpr size_t OFF_X1T  = OFF_D2 + (size_t)512 * 1024 * 2;
constexpr size_t OFF_ZR1  = OFF_X1T + (size_t)NTOK * 1024 * 2;
constexpr size_t OFF_ZR2  = OFF_ZR1 + (size_t)NTOK * 1024 * 2;
constexpr size_t OFF_VT   = OFF_ZR2 + (size_t)NTOK * 2048 * 2;
constexpr size_t OFF_GRN  = OFF_VT + (size_t)512 * NTOK * 2;
constexpr size_t GRN_WORDS = (size_t)192 * 4 * 4 * 256;
constexpr size_t OFF_BAR  = OFF_GRN + GRN_WORDS * 8;
constexpr size_t BAR_BYTES = 3456 * 4;
constexpr size_t WS_END   = OFF_BAR + BAR_BYTES;
constexpr size_t OUT_H  = 0;
constexpr size_t OUT_PT = (size_t)NTOK * 1024 * 2;
constexpr size_t OUT_PTS = OUT_PT + (size_t)16 * 512 * 2 * 2048 * 2;
constexpr size_t OUT_YA = 0;
constexpr size_t OUT_YB = (size_t)NTOK * 512 * 2;

struct Params {
    const float *x_p, *x_s, *c_p, *c_s, *norm_g, *w_ada, *b_ada, *w_in, *w_fmix, *b_fmix, *ln_g, *ln_b, *w_s, *b_s, *w_pa, *w_pb, *w_out, *final_g;
    float* out; unsigned char* ws;
};

#define TABI(i) ((i) + ((i) >> 5))
__device__ __forceinline__ int opaque_tid() { int t = threadIdx.x; asm volatile("" : "+v"(t)); return t; }
__device__ __forceinline__ unsigned cvt_pk_bf16(float lo, float hi) { unsigned r; asm volatile("v_cvt_pk_bf16_f32 %0, %1, %2" : "=v"(r) : "v"(lo), "v"(hi)); return r; }
__device__ __forceinline__ float bf_lo(unsigned w) { return __uint_as_float(w << 16); }
__device__ __forceinline__ float bf_hi(unsigned w) { return __uint_as_float(w & 0xffff0000u); }
__device__ __forceinline__ float sigm(float x) { return __builtin_amdgcn_rcpf(1.f + __builtin_amdgcn_exp2f(x * -1.4426950408889634f)); }
__device__ __forceinline__ float silu(float x) { return x * sigm(x); }
__device__ __forceinline__ float wave_sum(float v) {
#pragma unroll
    for (int o = 32; o > 0; o >>= 1) v += __shfl_xor(v, o, 64);
    return v;
}
__device__ __forceinline__ const float* xrow(const Params& p, int token) {
    return token < NTOK_P ? p.x_p + (size_t)token * D : p.x_s + (size_t)(token - NTOK_P) * D;
}
__device__ __forceinline__ int batch_of(int token) { return token < NTOK_P ? (token >> 11) : 16 + ((token - NTOK_P) >> 12); }

namespace pg8 {
constexpr int BM = 256, BK = 64, HALF = 128, HTB = HALF * BK * 2, NXCD = 8, WGM = 8;
__device__ __forceinline__ int lds_byte(int r, int c) { const int st = (r >> 4) * 2 + (c >> 5), rr = r & 15, cc = c & 31, ob = rr * 64 + cc * 2; return st * 1024 + (ob ^ (((ob >> 9) & 1) << 5)); }
__device__ __forceinline__ void stage_rc(int b, int& R, int& C) { const int st = b / 1024, sb = b % 1024, swz = sb ^ (((sb >> 9) & 1) << 5); R = (st >> 1) * 16 + swz / 64; C = (st & 1) * 32 + (swz % 64) / 2; }
__device__ __forceinline__ int perm32(int rho) { const int n = rho >> 4, i = rho & 15; return 8 * (i >> 2) + 4 * n + (i & 3); }

struct Unit { const char* A; const char* B; int pm, pn, kind, pad; };

__device__ __forceinline__ void tile_map(int L, int nM, int nN, int& pm, int& pn) {
    const int nwg = nM * nN; int wgid = L;
    { const int q = nwg / NXCD, r = nwg % NXCD, xcd = wgid % NXCD, off = wgid / NXCD; wgid = (xcd < r ? xcd * (q + 1) : r * (q + 1) + (xcd - r) * q) + off; }
    const int nig = WGM * nN, gid = wgid / nig, fm = gid * WGM, gsz = (nM - fm) < WGM ? (nM - fm) : WGM;
    pm = fm + ((wgid % nig) % gsz); pn = (wgid % nig) / gsz;
}

template <class Epi, class Sched>
__device__ __forceinline__ void gemm_phase(LAS unsigned char* lds, const int K, const Sched& S, const Epi& E) {
    const int tid = opaque_tid(), wid = __builtin_amdgcn_readfirstlane(tid >> 6), lane = tid & 63, wr = wid >> 2, wc = wid & 3, fr = lane & 15, fq = lane >> 4;
    const int nt = K / BK;
    unsigned voffA[2], voffB[2];
#pragma unroll
    for (int i = 0; i < 2; ++i) { int R, C; stage_rc(tid * 16 + i * 8192, R, C); const int Rb = Epi::PERM ? ((R & ~31) + perm32(R & 31)) : R;
        voffA[i] = (unsigned)(R * K + C) * 2u; voffB[i] = (unsigned)(Rb * K + C) * 2u; }
    const size_t kstep = (size_t)(BK * 2);
    const size_t hstep = (size_t)HALF * K * 2;
    const unsigned ldsw = (unsigned)wid * 1024u;
    const int aoff = lds_byte(wr * 64 + fr, fq * 8), boff = lds_byte(wc * 32 + fr, fq * 8);
#define PG8_SA(b, h) (((b) * 2 + (h)) * HTB)
#define PG8_SB(b, h) ((4 + (b) * 2 + (h)) * HTB)
#define PG8_STAGE(bufoff, gbase, voff) do { _Pragma("unroll") for (int _i = 0; _i < 2; ++_i) \
        __builtin_amdgcn_global_load_lds((const unsigned*)((const char*)(gbase) + (voff)[_i]), (LAS unsigned*)(lds + (bufoff) + ldsw + _i * 8192), 16, 0, 0); } while (0)
#define PG8_LDA(dst, b, h) do { _Pragma("unroll") for (int m = 0; m < 4; ++m) _Pragma("unroll") for (int k = 0; k < 2; ++k) dst[m][k] = *(const LAS bf16x8*)(lds + PG8_SA(b, h) + aoff + m * 2048 + k * 1024); } while (0)
#define PG8_LDB(dst, b, h) do { _Pragma("unroll") for (int n = 0; n < 2; ++n) _Pragma("unroll") for (int k = 0; k < 2; ++k) dst[n][k] = *(const LAS bf16x8*)(lds + PG8_SB(b, h) + boff + n * 2048 + k * 1024); } while (0)
#define PG8_MMA(ai, bj, At, Bt) do { __builtin_amdgcn_s_setprio(1); _Pragma("unroll") for (int m = 0; m < 4; ++m) _Pragma("unroll") for (int n = 0; n < 2; ++n) _Pragma("unroll") for (int k = 0; k < 2; ++k) \
        acc[ai][bj][m][n] = __builtin_amdgcn_mfma_f32_16x16x32_bf16(Bt[n][k], At[m][k], acc[ai][bj][m][n], 0, 0, 0); __builtin_amdgcn_s_setprio(0); } while (0)
#define PG8_WAIT_V(n) asm volatile("s_waitcnt vmcnt(" #n ")" ::: "memory")
#define PG8_WAIT_L(n) asm volatile("s_waitcnt lgkmcnt(" #n ")" ::: "memory")
#define PG8_BAR __builtin_amdgcn_s_barrier()
#define PG8_SCHED __builtin_amdgcn_sched_barrier(0)
    Unit cur, nxt; int ui = 0;
    if (!S.next(0, cur)) return;
    f32x4 acc[2][2][4][2];
#pragma unroll
    for (int a = 0; a < 2; ++a)
#pragma unroll
        for (int b = 0; b < 2; ++b)
#pragma unroll
            for (int m = 0; m < 4; ++m)
#pragma unroll
                for (int n = 0; n < 2; ++n) acc[a][b][m][n] = (f32x4){0.f, 0.f, 0.f, 0.f};
    bf16x8 At[4][2], B0[2][2], B1[2][2];
    const char* cA = cur.A; const char* cB = cur.B;
    PG8_STAGE(PG8_SB(0, 0), cB, voffB); PG8_STAGE(PG8_SA(0, 0), cA, voffA); PG8_STAGE(PG8_SB(0, 1), cB + hstep, voffB); PG8_STAGE(PG8_SA(0, 1), cA + hstep, voffA);
    if (wr == 1) PG8_BAR;
    PG8_WAIT_V(4); PG8_BAR;
    PG8_STAGE(PG8_SB(1, 0), cB + kstep, voffB); PG8_STAGE(PG8_SA(1, 0), cA + kstep, voffA); PG8_STAGE(PG8_SB(1, 1), cB + hstep + kstep, voffB);
    PG8_WAIT_V(6); PG8_BAR;
    for (;;) {
        const bool has_next = S.next(ui + 1, nxt);
        const char* nA = has_next ? nxt.A : cA; const char* nB = has_next ? nxt.B : cB;
        for (int t = 0; t < nt; t += 2) {
            const bool last = (t == nt - 2);
            const char* a1 = cA + (size_t)(t + 1) * kstep;
            const char* a2 = last ? nA : cA + (size_t)(t + 2) * kstep; const char* b2 = last ? nB : cB + (size_t)(t + 2) * kstep;
            const char* a3 = a2 + kstep; const char* b3 = b2 + kstep;
            PG8_LDB(B0, 0, 0); PG8_SCHED; PG8_LDA(At, 0, 0); PG8_STAGE(PG8_SA(1, 1), a1 + hstep, voffA);
            PG8_WAIT_L(8); PG8_BAR; PG8_WAIT_L(0); PG8_MMA(0, 0, At, B0); PG8_BAR; PG8_SCHED;
            PG8_LDB(B1, 0, 1); PG8_STAGE(PG8_SB(0, 0), b2, voffB);
            PG8_BAR; PG8_WAIT_L(0); PG8_MMA(0, 1, At, B1); PG8_BAR;
            PG8_LDA(At, 0, 1); PG8_STAGE(PG8_SA(0, 0), a2, voffA);
            PG8_BAR; PG8_WAIT_L(0); PG8_MMA(1, 0, At, B0); PG8_BAR; PG8_SCHED;
            PG8_STAGE(PG8_SB(0, 1), b2 + hstep, voffB);
            PG8_WAIT_V(6); PG8_BAR; PG8_MMA(1, 1, At, B1); PG8_BAR;
            PG8_LDB(B0, 1, 0); PG8_SCHED; PG8_LDA(At, 1, 0); PG8_STAGE(PG8_SA(0, 1), a2 + hstep, voffA);
            PG8_WAIT_L(8); PG8_BAR; PG8_WAIT_L(0); PG8_MMA(0, 0, At, B0); PG8_BAR; PG8_SCHED;
            PG8_LDB(B1, 1, 1); PG8_STAGE(PG8_SB(1, 0), b3, voffB);
            PG8_BAR; PG8_WAIT_L(0); PG8_MMA(0, 1, At, B1); PG8_BAR;
            PG8_LDA(At, 1, 1); PG8_STAGE(PG8_SA(1, 0), a3, voffA);
            PG8_BAR; PG8_WAIT_L(0); PG8_MMA(1, 0, At, B0); PG8_BAR; PG8_SCHED;
            PG8_STAGE(PG8_SB(1, 1), b3 + hstep, voffB);
            PG8_WAIT_V(6); PG8_BAR; PG8_MMA(1, 1, At, B1); PG8_BAR;
        }
        E(acc, cur, wr, wc, fr, fq);
        if (!has_next) break;
        if (!Epi::OWN_ACC && !(cur.kind & 1)) {
#pragma unroll
            for (int a = 0; a < 2; ++a)
#pragma unroll
                for (int b = 0; b < 2; ++b)
#pragma unroll
                    for (int m = 0; m < 4; ++m)
#pragma unroll
                        for (int n = 0; n < 2; ++n) acc[a][b][m][n] = (f32x4){0.f, 0.f, 0.f, 0.f};
        }
        cur = nxt; cA = nA; cB = nB; ++ui;
    }
    PG8_WAIT_V(0);
    if (wr == 0) PG8_BAR;
    PG8_BAR;
#undef PG8_SA
#undef PG8_SB
#undef PG8_STAGE
#undef PG8_LDA
#undef PG8_LDB
#undef PG8_MMA
#undef PG8_WAIT_V
#undef PG8_WAIT_L
#undef PG8_BAR
#undef PG8_SCHED
}
}
using pg8::Unit;

__device__ __forceinline__ u32x4 pack8(const f32x4& a, const f32x4& b) {
    u32x4 o; o[0] = cvt_pk_bf16(a[0], a[1]); o[1] = cvt_pk_bf16(a[2], a[3]); o[2] = cvt_pk_bf16(b[0], b[1]); o[3] = cvt_pk_bf16(b[2], b[3]); return o;
}

struct SchedG1 {
    const char* H; const char* WT1; int G, c;
    __device__ __forceinline__ bool next(int i, Unit& u) const {
        const long L = (long)i * G + c;
        if (L < 2688) { int pm, pn; pg8::tile_map((int)L, 192, 14, pm, pn); u.pm = pm; u.pn = pn; u.kind = 0; u.pad = 0;
            u.A = H + (size_t)pm * 256 * 1024 * 2; u.B = WT1 + (size_t)(1536 + pn * 256) * 1024 * 2; return true; }
        if (L < 3840) { int pm, pn; pg8::tile_map((int)(L - 2688), 6, 192, pm, pn); u.pm = pm; u.pn = pn; u.kind = 2; u.pad = 0;
            u.A = WT1 + (size_t)pm * 256 * 1024 * 2; u.B = H + (size_t)pn * 256 * 1024 * 2; return true; }
        return false;
    }
};
struct EpiG1 {
    static constexpr bool OWN_ACC = false;
    static constexpr bool PERM = true;
    bf16_t *ZR1, *ZR2, *PTp, *PTs, *VT;
    __device__ __forceinline__ void operator()(f32x4 (&acc)[2][2][4][2], const Unit& u, int wr, int wc, int fr_, int fq_) const {
        int fr = fr_, fq = fq_; asm volatile("" : "+v"(fr), "+v"(fq));
        if (u.kind == 0 && u.pn < 2) {
            bf16_t* base = ZR1 + u.pn * 256;
            const int row0 = u.pm * 256 + wr * 64 + fr, col0 = wc * 32 + 8 * fq;
#pragma unroll
            for (int ai = 0; ai < 2; ++ai)
#pragma unroll
                for (int m = 0; m < 4; ++m) { bf16_t* rowp = base + (size_t)(row0 + ai * 128 + m * 16) * 1024 + col0;
#pragma unroll
                    for (int bj = 0; bj < 2; ++bj) *(u32x4*)(rowp + bj * 128) = pack8(acc[ai][bj][m][0], acc[ai][bj][m][1]); }
        } else if (u.kind == 0 && u.pn < 6) {
            const int row0 = u.pm * 256 + wr * 64 + fr, col0 = 512 + (u.pn - 2) * 128 + wc * 32 + 8 * fq;
#pragma unroll
            for (int ai = 0; ai < 2; ++ai)
#pragma unroll
                for (int m = 0; m < 4; ++m) { f32x4 o0, o1;
#pragma unroll
                    for (int q = 0; q < 4; ++q) { o0[q] = acc[ai][0][m][0][q] * silu(acc[ai][1][m][0][q]); o1[q] = acc[ai][0][m][1][q] * silu(acc[ai][1][m][1][q]); }
                    *(u32x4*)(ZR1 + (size_t)(row0 + ai * 128 + m * 16) * 1024 + col0) = pack8(o0, o1); }
        } else if (u.kind == 0) {
            const int row0 = u.pm * 256 + wr * 64 + fr, col0 = (u.pn - 6) * 128 + wc * 32 + 8 * fq;
#pragma unroll
            for (int ai = 0; ai < 2; ++ai)
#pragma unroll
                for (int m = 0; m < 4; ++m) { bf16_t* rowp = ZR2 + (size_t)(row0 + ai * 128 + m * 16) * 2048 + col0;
                    f32x4 r0, r1, s0, s1;
#pragma unroll
                    for (int q = 0; q < 4; ++q) {
                        const float ea0 = __builtin_amdgcn_exp2f(acc[ai][0][m][0][q] * -1.4426950408889634f), ea1 = __builtin_amdgcn_exp2f(acc[ai][0][m][1][q] * -1.4426950408889634f);
                        const float eb0 = __builtin_amdgcn_exp2f(acc[ai][1][m][0][q] * -1.4426950408889634f), eb1 = __builtin_amdgcn_exp2f(acc[ai][1][m][1][q] * -1.4426950408889634f);
                        const float pa0 = 1.f + ea0, pb0 = 1.f + eb0, pa1 = 1.f + ea1, pb1 = 1.f + eb1;
                        const float t0 = __builtin_amdgcn_rcpf(pa0 * pb0), t1 = __builtin_amdgcn_rcpf(pa1 * pb1);
                        s0[q] = pa0 * t0; s1[q] = pa1 * t1; r0[q] = pb0 * pb0 * t0; r1[q] = pb1 * pb1 * t1; }
                    __builtin_nontemporal_store(pack8(r0, r1), (u32x4*)rowp); __builtin_nontemporal_store(pack8(s0, s1), (u32x4*)(rowp + 1024)); }
        } else {
#pragma unroll
            for (int bj = 0; bj < 2; ++bj) {
                const int t = u.pn * 256 + bj * 128 + wc * 32 + 8 * fq;
                bf16_t* base; size_t colstride, partstride;
                if (t < NTOK_P) { const int b = t >> 11, s = t & 2047; base = PTp + (size_t)b * 512 * 4096 + s; colstride = 4096; partstride = 2048; }
                else { const int tt = t - NTOK_P, b = tt >> 12, s = tt & 4095; base = PTs + (size_t)b * 512 * 4096 + s; colstride = 4096; partstride = (size_t)4 * 512 * 4096; }
#pragma unroll
                for (int ai = 0; ai < 2; ++ai)
#pragma unroll
                    for (int m = 0; m < 4; ++m) { const int r = u.pm * 256 + ai * 128 + wr * 64 + m * 16 + fr, part = r >> 9, col = r & 511;
                        bf16_t* dst = (u.pm < 4) ? base + (size_t)col * colstride + (size_t)part * partstride : VT + (size_t)col * NTOK + t;
                        *(u32x4*)dst = pack8(acc[ai][bj][m][0], acc[ai][bj][m][1]); }
            }
        }
    }
};

struct SchedD2 {
    const char *D2, *X1T; int G, c;
    __device__ __forceinline__ bool next(int i, Unit& u) const {
        const long L = (long)i * G + c;
        if (L >= 384) return false;
        u.pm = (int)L & 1; u.pn = (int)L >> 1; u.kind = 0; u.pad = 0;
        u.A = D2 + (size_t)u.pm * 256 * 1024 * 2; u.B = X1T + (size_t)u.pn * 256 * 1024 * 2; return true;
    }
};
struct EpiD2 {
    static constexpr bool OWN_ACC = false;
    static constexpr bool PERM = true;
    const bf16_t* ZR1; bf16_t* YA; const float* b_fmix;
    __device__ __forceinline__ void operator()(f32x4 (&acc)[2][2][4][2], const Unit& u, int wr, int wc, int fr_, int fq_) const {
        int fr = fr_, fq = fq_; asm volatile("" : "+v"(fr), "+v"(fq));
#pragma unroll
        for (int bj = 0; bj < 2; ++bj) {
            const int n = u.pn * 256 + bj * 128 + wc * 32 + 8 * fq, col = n & 511;
            int k1, tokb, n1;
            if (n < 32768) { k1 = n >> 13; tokb = ((n >> 9) & 15) * SP; n1 = 4; }
            else { const int nn = n - 32768; k1 = nn >> 11; tokb = NTOK_P + ((nn >> 9) & 3) * SS; n1 = 8; }
            const f32x4 bv0 = *(const f32x4*)(b_fmix + col), bv1 = *(const f32x4*)(b_fmix + col + 4);
            u32x4 gv[2][4];
#pragma unroll
            for (int ai = 0; ai < 2; ++ai)
#pragma unroll
                for (int m = 0; m < 4; ++m) { const int k2 = u.pm * 256 + ai * 128 + wr * 64 + m * 16 + fr; gv[ai][m] = __builtin_nontemporal_load((const u32x4*)(ZR1 + (size_t)(tokb + k1 + n1 * k2) * 1024 + col)); }
#pragma unroll
            for (int ai = 0; ai < 2; ++ai)
#pragma unroll
                for (int m = 0; m < 4; ++m) { const int k2 = u.pm * 256 + ai * 128 + wr * 64 + m * 16 + fr; const size_t token = (size_t)(tokb + k1 + n1 * k2);
                    const u32x4 g = gv[ai][m];
                    f32x4 v0 = acc[ai][bj][m][0] + bv0, v1 = acc[ai][bj][m][1] + bv1;
                    v0[0] *= silu(bf_lo(g[0])); v0[1] *= silu(bf_hi(g[0])); v0[2] *= silu(bf_lo(g[1])); v0[3] *= silu(bf_hi(g[1]));
                    v1[0] *= silu(bf_lo(g[2])); v1[1] *= silu(bf_hi(g[2])); v1[2] *= silu(bf_lo(g[3])); v1[3] *= silu(bf_hi(g[3]));
                    *(u32x4*)(YA + token * 512 + col) = pack8(v0, v1); }
        }
    }
};

template <int W8> __device__ __forceinline__ void cmac8(float& xr, float& xi, float zr, float zi) {
    constexpr float R = 0.70710678118654752f;
    if (W8 == 0) { xr += zr; xi += zi; }
    else if (W8 == 1) { xr += R * (zr + zi); xi += R * (zi - zr); }
    else if (W8 == 2) { xr += zi; xi -= zr; }
    else if (W8 == 3) { xr += R * (zi - zr); xi -= R * (zi + zr); }
    else if (W8 == 4) { xr -= zr; xi -= zi; }
    else if (W8 == 5) { xr -= R * (zr + zi); xi += R * (zr - zi); }
    else if (W8 == 6) { xr -= zi; xi += zr; }
    else { xr += R * (zr - zi); xi += R * (zr + zi); }
}
template <int N1, int NP, int K1, int S1> struct DftAcc {
    static __device__ __forceinline__ void run(float (&xr)[NP], float (&xi)[NP], const float (&zr)[N1][NP], const float (&zi)[N1][NP]) {
#pragma unroll
        for (int j = 0; j < NP; ++j) cmac8<((K1 * S1) % N1) * (8 / N1)>(xr[j], xi[j], zr[S1][j], zi[S1][j]);
        if constexpr (S1 + 1 < N1) DftAcc<N1, NP, K1, S1 + 1>::run(xr, xi, zr, zi);
    }
};
template <int N1, int NP, int K1> struct DftK {
    static __device__ __forceinline__ void run(const float (&zr)[N1][NP], const float (&zi)[N1][NP], const float* tab, int s20, float scale, bf16_t* dst, size_t k1stride) {
        constexpr int SEQ = N1 * 512;
        float xr[NP], xi[NP];
#pragma unroll
        for (int j = 0; j < NP; ++j) { xr[j] = 0.f; xi[j] = 0.f; }
        DftAcc<N1, NP, K1, 0>::run(xr, xi, zr, zi);
        float yr[NP], yi[NP];
#pragma unroll
        for (int j = 0; j < NP; ++j) { const int ti = ((K1 * (s20 + j)) & (SEQ - 1)) * (4096 / SEQ);
            const float ct = tab[TABI(ti)] * scale, st = tab[TABI((ti - 1024) & 4095)] * scale;
            yr[j] = ct * xr[j] + st * xi[j]; yi[j] = ct * xi[j] - st * xr[j]; }
        bf16_t* d = dst + (size_t)K1 * k1stride;
        if constexpr (NP == 8) { u32x4 o0, o1;
#pragma unroll
            for (int j = 0; j < 4; ++j) { o0[j] = cvt_pk_bf16(yr[2 * j], yr[2 * j + 1]); o1[j] = cvt_pk_bf16(yi[2 * j], yi[2 * j + 1]); }
            *(u32x4*)d = o0; *(u32x4*)(d + 512) = o1;
        } else { u32x2 o0, o1;
#pragma unroll
            for (int j = 0; j < 2; ++j) { o0[j] = cvt_pk_bf16(yr[2 * j], yr[2 * j + 1]); o1[j] = cvt_pk_bf16(yi[2 * j], yi[2 * j + 1]); }
            *(u32x2*)d = o0; *(u32x2*)(d + 512) = o1; }
        if constexpr (K1 + 1 < N1) DftK<N1, NP, K1 + 1>::run(zr, zi, tab, s20, scale, dst, k1stride);
    }
};
template <int N1, int NP> __device__ __forceinline__ void dft1_item(const bf16_t* re, const bf16_t* im, const float* tab, int s20, float scale, bf16_t* dst, size_t k1stride) {
    float zr[N1][NP], zi[N1][NP];
    if constexpr (NP == 8) {
        u32x4 a[N1], b[N1];
#pragma unroll
        for (int s1 = 0; s1 < N1; ++s1) { a[s1] = __builtin_nontemporal_load((const u32x4*)(re + 512 * s1 + s20)); b[s1] = __builtin_nontemporal_load((const u32x4*)(im + 512 * s1 + s20)); }
#pragma unroll
        for (int s1 = 0; s1 < N1; ++s1)
#pragma unroll
            for (int j = 0; j < 4; ++j) { zr[s1][2 * j] = bf_lo(a[s1][j]); zr[s1][2 * j + 1] = bf_hi(a[s1][j]); zi[s1][2 * j] = -bf_lo(b[s1][j]); zi[s1][2 * j + 1] = -bf_hi(b[s1][j]); }
    } else {
        u32x2 a[N1], b[N1];
#pragma unroll
        for (int s1 = 0; s1 < N1; ++s1) { a[s1] = __builtin_nontemporal_load((const u32x2*)(re + 512 * s1 + s20)); b[s1] = __builtin_nontemporal_load((const u32x2*)(im + 512 * s1 + s20)); }
#pragma unroll
        for (int s1 = 0; s1 < N1; ++s1)
#pragma unroll
            for (int j = 0; j < 2; ++j) { zr[s1][2 * j] = bf_lo(a[s1][j]); zr[s1][2 * j + 1] = bf_hi(a[s1][j]); zi[s1][2 * j] = -bf_lo(b[s1][j]); zi[s1][2 * j + 1] = -bf_hi(b[s1][j]); }
    }
    DftK<N1, NP, 0>::run(zr, zi, tab, s20, scale, dst, k1stride);
}
__device__ void dft_stage1(const Params& p, unsigned char* shm) {
    const int tid = opaque_tid();
    float* tab = (float*)shm;
    for (int j = tid; j < 4096; j += 512) tab[TABI(j)] = cospif((float)j * (1.0f / 2048.0f));
    __syncthreads();
    const bf16_t* PTp = (const bf16_t*)((unsigned char*)p.out + OUT_PT); const bf16_t* PTs = (const bf16_t*)((unsigned char*)p.out + OUT_PTS);
    bf16_t* X1T = (bf16_t*)(p.ws + OFF_X1T);
#pragma unroll 1
    for (int it = blockIdx.x * 512 + tid; it < 16 * 512 * 64; it += gridDim.x * 512) {
        const int g = it & 63, col = (it >> 6) & 511, b = it >> 15;
        const bf16_t* re = PTp + (size_t)(b * 512 + col) * 4096;
        dft1_item<4, 8>(re, re + 2048, tab, g * 8, 0.02209708691207961f, X1T + (size_t)(b * 512 + col) * 1024 + g * 8, (size_t)16 * 512 * 1024);
    }
#pragma unroll 1
    for (int it = blockIdx.x * 512 + tid; it < 4 * 512 * 128; it += gridDim.x * 512) {
        const int g = it & 127, col = (it >> 7) & 511, b = it >> 16;
        const bf16_t* re = PTs + (size_t)(b * 512 + col) * 4096;
        dft1_item<8, 4>(re, re + (size_t)4 * 512 * 4096, tab, g * 4, 0.015625f, X1T + (size_t)(32768 + b * 512 + col) * 1024 + g * 4, (size_t)4 * 512 * 1024);
    }
}

struct SchedG2 {
    const char *YA, *YB, *WPA, *WPB; int G, c;
    __device__ __forceinline__ bool next(int i, Unit& u) const {
        const long L = (long)(i >> 1) * G + c; const int sub = i & 1;
        if (L >= 768) return false;
        int pm, pn; pg8::tile_map((int)L, 192, 4, pm, pn); u.pm = pm; u.pn = pn; u.kind = sub ? 0 : 1; u.pad = 0;
        u.A = (sub ? YB : YA) + (size_t)pm * 256 * 512 * 2; u.B = (sub ? WPB : WPA) + (size_t)pn * 256 * 512 * 2; return true;
    }
};
struct EpiG2 {
    static constexpr bool PERM = true, OWN_ACC = true;
    const bf16_t* ZR2; bf16_t* MG;
    __device__ __forceinline__ void operator()(f32x4 (&acc)[2][2][4][2], const Unit& u, int wr, int wc, int fr_, int fq_) const {
        int fr = fr_, fq = fq_; asm volatile("" : "+v"(fr), "+v"(fq));
        const int row0 = u.pm * 256 + wr * 64 + fr, col0 = u.pn * 256 + wc * 32 + 8 * fq;
        const bool keep = (u.kind & 1) != 0;
        const float kf = keep ? 1.f : 0.f;
        const int zoff = keep ? 0 : 1024;
        u32x4 bv[2][4][2];
#pragma unroll
        for (int ai = 0; ai < 2; ++ai)
#pragma unroll
            for (int m = 0; m < 4; ++m)
#pragma unroll
                for (int bj = 0; bj < 2; ++bj) bv[ai][m][bj] = __builtin_nontemporal_load((const u32x4*)(ZR2 + (size_t)(row0 + ai * 128 + m * 16) * 2048 + zoff + col0 + bj * 128));
#pragma unroll
        for (int ai = 0; ai < 2; ++ai) {
#pragma unroll
            for (int m = 0; m < 4; ++m) { const size_t row = (size_t)(row0 + ai * 128 + m * 16);
#pragma unroll
                for (int bj = 0; bj < 2; ++bj) { const u32x4 b = bv[ai][m][bj];
                    f32x4 v0 = acc[ai][bj][m][0], v1 = acc[ai][bj][m][1];
                    v0[0] *= bf_lo(b[0]); v0[1] *= bf_hi(b[0]); v0[2] *= bf_lo(b[1]); v0[3] *= bf_hi(b[1]);
                    v1[0] *= bf_lo(b[2]); v1[1] *= bf_hi(b[2]); v1[2] *= bf_lo(b[3]); v1[3] *= bf_hi(b[3]);
                    if (!keep) *(u32x4*)(MG + row * 1024 + col0 + bj * 128) = pack8(v0, v1);
                    acc[ai][bj][m][0] = v0 * kf; acc[ai][bj][m][1] = v1 * kf; } }
        }
    }
};

struct SchedG3 {
    const char *MG, *WOUT; int G, c;
    __device__ __forceinline__ bool next(int i, Unit& u) const {
        const int q = G >> 2, pn = c / q, pm = i * q + c % q;
        if (pm >= 192) return false;
        u.pm = pm; u.pn = pn; u.kind = 0; u.pad = 0;
        u.A = MG + (size_t)pm * 256 * 1024 * 2; u.B = WOUT + (size_t)pn * 256 * 1024 * 2; return true;
    }
};
typedef __attribute__((address_space(1))) unsigned long long gu64;
struct EpiG3 {     static constexpr bool OWN_ACC = false;
    static constexpr bool PERM = false;
    const float *x_p, *x_s, *GATE, *final_g; float* out; unsigned long long* GRN;
    __device__ __forceinline__ void operator()(f32x4 (&acc)[2][2][4][2], const Unit& u, int wr, int wc, int fr_, int fq_) const {
        int fr = fr_, fq = fq_; asm volatile("" : "+v"(fr), "+v"(fq));
        const int row0 = u.pm * 256 + wr * 64 + fr, col0 = u.pn * 256 + wc * 32 + 4 * fq;
        const int b = batch_of(u.pm * 256);
        float rs[2][4];
        {
            f32x4 gv[2][2];
#pragma unroll
            for (int bj = 0; bj < 2; ++bj)
#pragma unroll
                for (int n = 0; n < 2; ++n) gv[bj][n] = *(const f32x4*)(GATE + b * 1024 + col0 + bj * 128 + n * 16);
#pragma unroll
            for (int ai = 0; ai < 2; ++ai)
#pragma unroll
                for (int m = 0; m < 4; ++m) { const int row = row0 + ai * 128 + m * 16;
                    const float* xr = (row < NTOK_P ? x_p + (size_t)row * D : x_s + (size_t)(row - NTOK_P) * D) + col0;
                    float ss = 0.f;
#pragma unroll
                    for (int bj = 0; bj < 2; ++bj)
#pragma unroll
                        for (int n = 0; n < 2; ++n) { const f32x4 xv = __builtin_nontemporal_load((const f32x4*)(xr + bj * 128 + n * 16));
                            const f32x4 y = xv + gv[bj][n] * acc[ai][bj][m][n]; acc[ai][bj][m][n] = y;
                            ss += y[0] * y[0] + y[1] * y[1] + y[2] * y[2] + y[3] * y[3]; }
                    ss += __shfl_xor(ss, 16, 64); ss += __shfl_xor(ss, 32, 64);
                    rs[ai][m] = ss; }
        }
        float w0 = 0.f, w1 = 0.f;
#pragma unroll
        for (int jj = 0; jj < 8; ++jj) { if ((jj >> 1) == fq) { if (jj & 1) w1 = rs[jj >> 2][jj & 3]; else w0 = rs[jj >> 2][jj & 3]; } }
        const int jj0 = 2 * fq, jj1 = 2 * fq + 1;
        const int lr0 = (jj0 >> 2) * 128 + wr * 64 + (jj0 & 3) * 16 + fr, lr1 = (jj1 >> 2) * 128 + wr * 64 + (jj1 & 3) * 16 + fr;
        gu64* gp = (gu64*)GRN + (size_t)u.pm * (4 * 4 * 256);
        __hip_atomic_store(gp + ((u.pn * 4 + wc) * 256 + lr0), (1ull << 32) | (unsigned long long)__float_as_uint(w0), __ATOMIC_RELAXED, __HIP_MEMORY_SCOPE_AGENT);
        __hip_atomic_store(gp + ((u.pn * 4 + wc) * 256 + lr1), (1ull << 32) | (unsigned long long)__float_as_uint(w1), __ATOMIC_RELAXED, __HIP_MEMORY_SCOPE_AGENT);
        float t0 = 0.f, t1 = 0.f;
        for (unsigned spins = 0;; ++spins) {
            bool ok = true; t0 = 0.f; t1 = 0.f;
#pragma unroll 4
            for (int k = 0; k < 16; ++k) {
                const unsigned long long a = __hip_atomic_load(gp + (k * 256 + lr0), __ATOMIC_RELAXED, __HIP_MEMORY_SCOPE_AGENT);
                const unsigned long long c = __hip_atomic_load(gp + (k * 256 + lr1), __ATOMIC_RELAXED, __HIP_MEMORY_SCOPE_AGENT);
                ok &= ((a >> 32) == 1ull) & ((c >> 32) == 1ull);
                t0 += __uint_as_float((unsigned)a); t1 += __uint_as_float((unsigned)c); }
            if (__all(ok) || spins > (1u << 20)) break;
            __builtin_amdgcn_s_sleep(4);
        }
        const float ri0 = rsqrtf(t0 * (1.0f / 1024.0f) + 1e-6f), ri1 = rsqrtf(t1 * (1.0f / 1024.0f) + 1e-6f);
        f32x4 fg[2][2];
#pragma unroll
        for (int bj = 0; bj < 2; ++bj)
#pragma unroll
            for (int n = 0; n < 2; ++n) fg[bj][n] = *(const f32x4*)(final_g + col0 + bj * 128 + n * 16);
#pragma unroll
        for (int ai = 0; ai < 2; ++ai)
#pragma unroll
            for (int m = 0; m < 4; ++m) { const int jj = ai * 4 + m; const int row = row0 + ai * 128 + m * 16;
                const float rinv = __shfl((jj & 1) ? ri1 : ri0, fr + 16 * (jj >> 1), 64);
                float* orow = out + (size_t)row * D + col0;
#pragma unroll
                for (int bj = 0; bj < 2; ++bj)
#pragma unroll
                    for (int n = 0; n < 2; ++n) *(f32x4*)(orow + bj * 128 + n * 16) = acc[ai][bj][m][n] * rinv * fg[bj][n]; }
    }
};

__device__ __forceinline__ int win_dstrow(int src) {
    if (src < 1024) return src + 1024;
    if (src < 1536) { const int m = src - 1024; return 2048 + (m >> 7) * 256 + (m & 127); }
    if (src < 2048) return src - 512;
    if (src < 2560) { const int m = src - 2048; return 2048 + (m >> 7) * 256 + 128 + (m & 127); }
    if (src < 3584) { const int m = src - 2560; return 3072 + (m >> 7) * 256 + (m & 127); }
    const int m = src - 3584; return 3072 + (m >> 7) * 256 + 128 + (m & 127);
}
template <bool WIN> __device__ __forceinline__ void transpose_item(const float* src, int src_pitch, int r0, int c0, bf16_t* dst, int dst_row0, int dst_pitch, float* tl, int tid) {
    f32x4 v[8];
#pragma unroll
    for (int i = 0; i < 8; ++i) { const int idx = i * 512 + tid, rr = idx >> 6, c4 = idx & 63; v[i] = __builtin_nontemporal_load((const f32x4*)(src + (size_t)(r0 + rr) * src_pitch + c0 + c4 * 4)); }
#pragma unroll
    for (int i = 0; i < 8; ++i) { const int idx = i * 512 + tid, rr = idx >> 6, c4 = idx & 63;
        *(f32x4*)(tl + rr * 260 + c4 * 4) = v[i]; }
    __syncthreads();
    const int cc = tid >> 1, half = tid & 1;
    const int drow = WIN ? win_dstrow(c0 + cc) : dst_row0 + cc;
    bf16_t* d = dst + (size_t)drow * dst_pitch + r0 + half * 32;
#pragma unroll
    for (int q = 0; q < 4; ++q) { u32x4 o;
#pragma unroll
        for (int i = 0; i < 4; ++i) o[i] = cvt_pk_bf16(tl[(half * 32 + q * 8 + 2 * i) * 260 + cc], tl[(half * 32 + q * 8 + 2 * i + 1) * 260 + cc]);
        *(u32x4*)(d + q * 8) = o; }
}

__device__ void phase0(const Params& p, unsigned char* shm) {
    const int tid0 = opaque_tid();
    float* tab = (float*)shm;
    float* scr = (float*)(shm + 17408);
    unsigned char* ws = p.ws;
    for (int j = tid0; j < 4096; j += 512) tab[TABI(j)] = cospif((float)j * (1.0f / 2048.0f));
    { unsigned long long* grn = (unsigned long long*)(p.ws + OFF_GRN);
      for (size_t i = (size_t)blockIdx.x * 512 + tid0; i < GRN_WORDS; i += (size_t)gridDim.x * 512) grn[i] = 0ull; }
    __syncthreads();
    constexpr int I_MOD = 384, I_TIN = I_MOD + 256, I_TPA = I_TIN + 32, I_TPB = I_TPA + 32, I_TOUT = I_TPB + 64, I_FOLD = I_TOUT + 256, I_WS = I_FOLD + 8, I_DFT = I_WS + 128;
    for (int item = blockIdx.x; item < I_DFT; item += gridDim.x) {
        int tid = tid0; asm volatile("" : "+v"(tid));
        const int w = tid >> 6, lane = tid & 63;
        if (item < I_MOD) {
            const int jt = item % 48, kc = item / 48;
            float* sc = scr; float* red = scr + 2560;
            const int j = jt * 64 + lane;
            float wv[16], cv[5];
#pragma unroll
            for (int kk = 0; kk < 16; ++kk) wv[kk] = __builtin_nontemporal_load(p.w_ada + (size_t)(kc * 128 + w * 16 + kk) * 3072 + j);
#pragma unroll
            for (int i = 0; i < 5; ++i) { const int idx = tid + i * 512, b = idx >> 7, k = kc * 128 + (idx & 127); cv[i] = b < 16 ? p.c_p[b * 1024 + k] : p.c_s[(b - 16) * 1024 + k]; }
#pragma unroll
            for (int i = 0; i < 5; ++i) sc[tid + i * 512] = silu(cv[i]);
            __syncthreads();
            float acc[NB];
#pragma unroll
            for (int b = 0; b < NB; ++b) acc[b] = 0.f;
#pragma unroll
            for (int kk = 0; kk < 16; ++kk) { const int kl = w * 16 + kk;
#pragma unroll
                for (int b = 0; b < NB; ++b) acc[b] += sc[b * 128 + kl] * wv[kk]; }
#pragma unroll
            for (int b = 0; b < NB; ++b) red[(w * NB + b) * 64 + lane] = acc[b];
            __syncthreads();
            for (int idx = tid; idx < NB * 64; idx += 512) { const int b = idx >> 6, l = idx & 63; float s = 0.f;
#pragma unroll
                for (int ww = 0; ww < 8; ++ww) s += red[(ww * NB + b) * 64 + l];
                const int jj = jt * 64 + l; if (kc == 0) s += p.b_ada[jj];
                ((float*)(ws + OFF_MODP))[(size_t)(kc * NB + b) * 3072 + jj] = s; }
        } else if (item < I_TIN) {
            const int it = item - I_MOD, rt = it & 15, ct = it >> 4;
            transpose_item<true>(p.w_in, INW, rt * 64, 512 + ct * 256, (bf16_t*)(ws + OFF_WT1), 0, 1024, scr, tid);
        } else if (item < I_TPA) {
            const int it = item - I_TIN, rt = it & 7, ct = it >> 3;
            transpose_item<false>(p.w_pa, 1024, rt * 64, ct * 256, (bf16_t*)(ws + OFF_WPA), ct * 256, 512, scr, tid);
        } else if (item < I_TPB) {
            const int it = item - I_TPA, rt = it & 7, ct = it >> 3;
            transpose_item<false>(p.w_pb, 1024, rt * 64, ct * 256, (bf16_t*)(ws + OFF_WPB), ct * 256, 512, scr, tid);
        } else if (item < I_TOUT) {
            const int it = item - I_TPB, rt = it & 15, ct = it >> 4;
            transpose_item<false>(p.w_out, 1024, rt * 64, ct * 256, (bf16_t*)(ws + OFF_WOUT), ct * 256, 1024, scr, tid);
        } else if (item < I_FOLD) {
            const int it = item - I_TOUT, dt = it & 31, pg = it >> 5, part = pg >> 2, g = pg & 3, d0 = dt * 32;
            float* wt = scr; float* U = scr + 4096;
            { const int rr = tid >> 4, cc = (tid & 15) * 8; const float* s = p.w_in + (size_t)(d0 + rr) * INW + g * 128 + cc;
              const f32x4 a = __builtin_nontemporal_load((const f32x4*)s), b = __builtin_nontemporal_load((const f32x4*)(s + 4));
#pragma unroll
              for (int i = 0; i < 4; ++i) { wt[rr * 128 + cc + i] = a[i]; wt[rr * 128 + cc + 4 + i] = b[i]; } }
            __syncthreads();
            const int m = tid & 127, ddg = tid >> 7;
            float acc[8];
#pragma unroll
            for (int i = 0; i < 8; ++i) acc[i] = 0.f;
#pragma unroll 2
            for (int c = 0; c < 128; c += 4) { f32x4 tv;
#pragma unroll
                for (int k = 0; k < 4; ++k) { const int idx = (((c + k) * m) & 127) * 32; tv[k] = part ? tab[TABI((idx - 1024) & 4095)] : tab[TABI(idx)]; }
#pragma unroll
                for (int i = 0; i < 8; ++i) { const f32x4 wv = *(const f32x4*)(wt + (ddg * 8 + i) * 128 + c); acc[i] += wv[0] * tv[0] + wv[1] * tv[1] + wv[2] * tv[2] + wv[3] * tv[3]; } }
#pragma unroll
            for (int i = 0; i < 8; ++i) U[(ddg * 8 + i) * 128 + m] = acc[i];
            __syncthreads();
#pragma unroll
            for (int i = 0; i < 8; ++i) acc[i] = 0.f;
#pragma unroll 2
            for (int mm = 0; mm < 128; mm += 4) { f32x4 fv;
#pragma unroll
                for (int k = 0; k < 4; ++k) fv[k] = p.w_fmix[(size_t)(g * 128 + mm + k) * 128 + m];
#pragma unroll
                for (int i = 0; i < 8; ++i) { const f32x4 uv = *(const f32x4*)(U + (ddg * 8 + i) * 128 + mm); acc[i] += uv[0] * fv[0] + uv[1] * fv[1] + uv[2] * fv[2] + uv[3] * fv[3]; } }
            const float sc = 0.08838834764831845f;
            u32x4 o;
#pragma unroll
            for (int i = 0; i < 4; ++i) o[i] = cvt_pk_bf16(acc[2 * i] * sc, acc[2 * i + 1] * sc);
            *(u32x4*)((bf16_t*)(ws + OFF_WT1) + (size_t)(part * 512 + g * 128 + m) * 1024 + d0 + ddg * 8) = o;
        } else if (item < I_WS) {
            const int it = item - I_FOLD; const size_t e = (size_t)it * 8192 + tid * 16; const float* s = p.w_s + e;
            const f32x4 a = *(const f32x4*)s, b = *(const f32x4*)(s + 4), c = *(const f32x4*)(s + 8), d = *(const f32x4*)(s + 12);
            bf16_t* dst = (bf16_t*)(ws + OFF_WSS) + e;
            *(u32x4*)dst = pack8(a, b); *(u32x4*)(dst + 8) = pack8(c, d);
        } else {
            const int r = item - I_WS, k2 = r * 4 + (tid >> 7), e0 = (tid & 127) * 8, part = e0 >> 9;
            float v[8]; bf16_t* dst = (bf16_t*)(ws + OFF_D2) + (size_t)k2 * 1024 + e0;
#pragma unroll
            for (int i = 0; i < 8; ++i) { const int s2 = (e0 + i) & 511, j8 = ((k2 * s2) & 511) * 8; v[i] = part ? tab[TABI((j8 - 1024) & 4095)] : tab[TABI(j8)]; }
            u32x4 o;
#pragma unroll
            for (int i = 0; i < 4; ++i) o[i] = cvt_pk_bf16(v[2 * i], v[2 * i + 1]);
            *(u32x4*)dst = o;
        }
        __syncthreads();
    }
}

__device__ void phase1(const Params& p, unsigned char* shm) {
    const int tid = opaque_tid(), w = tid >> 6, lane = tid & 63;
    float* cA = (float*)shm; float* cB = cA + 1024;
    const float* MODP = (const float*)(p.ws + OFF_MODP); float* GATE = (float*)(p.ws + OFF_GATE);
    bf16_t* H = (bf16_t*)((unsigned char*)p.out + OUT_H);
    for (int b = blockIdx.x; b < NB; b += gridDim.x)
        for (int n = tid; n < 1024; n += 512) { float s = 0.f;
#pragma unroll
            for (int kc = 0; kc < 8; ++kc) s += MODP[(size_t)(kc * NB + b) * 3072 + 2048 + n];
            GATE[b * 1024 + n] = s; }
    for (int g = blockIdx.x; g < NTOK / 64; g += gridDim.x) {
        const int token0 = g * 64, b = batch_of(token0);
        __syncthreads();
        for (int d = tid; d < 1024; d += 512) { float sh = 0.f, sc = 0.f;
#pragma unroll
            for (int kc = 0; kc < 8; ++kc) { sh += MODP[(size_t)(kc * NB + b) * 3072 + d]; sc += MODP[(size_t)(kc * NB + b) * 3072 + 1024 + d]; }
            cA[d] = p.norm_g[d] * (1.f + sc); cB[d] = sh; }
        __syncthreads();
        const f32x4 a0 = *(const f32x4*)(cA + lane * 8), a1 = *(const f32x4*)(cA + lane * 8 + 4), a2 = *(const f32x4*)(cA + 512 + lane * 8), a3 = *(const f32x4*)(cA + 512 + lane * 8 + 4);
        const f32x4 b0 = *(const f32x4*)(cB + lane * 8), b1 = *(const f32x4*)(cB + lane * 8 + 4), b2 = *(const f32x4*)(cB + 512 + lane * 8), b3 = *(const f32x4*)(cB + 512 + lane * 8 + 4);
#pragma unroll 1
        for (int r4 = 0; r4 < 8; r4 += 4) {
            f32x4 v[4][4];
#pragma unroll
            for (int j = 0; j < 4; ++j) { const float* xr = xrow(p, token0 + w * 8 + r4 + j);
                v[j][0] = __builtin_nontemporal_load((const f32x4*)(xr + lane * 8)); v[j][1] = __builtin_nontemporal_load((const f32x4*)(xr + lane * 8 + 4)); v[j][2] = __builtin_nontemporal_load((const f32x4*)(xr + 512 + lane * 8)); v[j][3] = __builtin_nontemporal_load((const f32x4*)(xr + 512 + lane * 8 + 4)); }
#pragma unroll
            for (int j = 0; j < 4; ++j) {
                float ss = 0.f;
#pragma unroll
                for (int i = 0; i < 4; ++i) ss += v[j][0][i] * v[j][0][i] + v[j][1][i] * v[j][1][i] + v[j][2][i] * v[j][2][i] + v[j][3][i] * v[j][3][i];
                ss = wave_sum(ss);
                const float rinv = rsqrtf(ss * (1.0f / 1024.0f) + 1e-6f);
                bf16_t* hr = H + (size_t)(token0 + w * 8 + r4 + j) * 1024;
                *(u32x4*)(hr + lane * 8) = pack8(v[j][0] * rinv * a0 + b0, v[j][1] * rinv * a1 + b1);
                *(u32x4*)(hr + 512 + lane * 8) = pack8(v[j][2] * rinv * a2 + b2, v[j][3] * rinv * a3 + b3);
            }
        }
    }
}

__device__ __forceinline__ int sgu_swz(int c) { return ((c & 3) << 2) | ((c >> 4) & 3); }
__device__ void sgu_chunk(const Params& p, unsigned char* shm, int chunk) {
    const int tid = opaque_tid(), w = tid >> 6, lane = tid & 63;
    const bf16_t* ZR1 = (const bf16_t*)(p.ws + OFF_ZR1);
    const bf16_t* VT = (const bf16_t*)(p.ws + OFF_VT);
    const bf16_t* WSS = (const bf16_t*)(p.ws + OFF_WSS);
    bf16_t* YB = (bf16_t*)((unsigned char*)p.out + OUT_YB);
    float* st = (float*)(shm + 131072);
    float* mr = st + 1024;
    const int t0 = chunk * 128;
    {
        u32x4 raw[16];
#pragma unroll
        for (int it = 0; it < 16; ++it) { const int idx = it * 512 + tid, c = idx >> 4, g = idx & 15; raw[it] = __builtin_nontemporal_load((const u32x4*)(VT + (size_t)c * NTOK + t0 + g * 8)); }
#pragma unroll
        for (int it = 0; it < 16; ++it) { const int idx = it * 512 + tid, c = idx >> 4, g = idx & 15; *(u32x4*)(shm + c * 256 + ((g ^ sgu_swz(c)) << 4)) = raw[it]; }
    }
    const float lg = p.ln_g[tid], lb = p.ln_b[tid];
    const int h = w >> 1, c0 = h * 128 + (w & 1) * 64, fr = lane & 15, fq = lane >> 4;
    u32x4 uu[4][2][2];
#pragma unroll
    for (int ph = 0; ph < 4; ++ph)
#pragma unroll
        for (int pt = 0; pt < 2; ++pt) { const size_t token = (size_t)t0 + ph * 32 + pt * 16 + fr; const bf16_t* zr = ZR1 + token * 1024 + 512 + c0 + fq * 16;
            uu[ph][pt][0] = __builtin_nontemporal_load((const u32x4*)zr); uu[ph][pt][1] = __builtin_nontemporal_load((const u32x4*)(zr + 8)); }
    __syncthreads();
    {
        const int q = tid & 127, qr = tid >> 7;
        float s = 0.f, ss = 0.f;
#pragma unroll 8
        for (int cc = 0; cc < 128; ++cc) { const int c = qr * 128 + cc;
            const float v = __uint_as_float((unsigned)(*(const bf16_t*)(shm + c * 256 + ((((q >> 3) ^ sgu_swz(c)) << 4) | ((q & 7) * 2)))) << 16);
            s += v; ss += v * v; }
        st[(qr * 128 + q) * 2] = s; st[(qr * 128 + q) * 2 + 1] = ss;
    }
    __syncthreads();
    if (tid < 128) { float s = 0.f, ss = 0.f;
#pragma unroll
        for (int qr = 0; qr < 4; ++qr) { s += st[(qr * 128 + tid) * 2]; ss += st[(qr * 128 + tid) * 2 + 1]; }
        const float mean = s * (1.0f / 512.0f); float var = ss * (1.0f / 512.0f) - mean * mean; var = var < 0.f ? 0.f : var;
        mr[tid] = mean; mr[128 + tid] = rsqrtf(var + 1e-6f); }
    __syncthreads();
    st[tid] = lg; st[512 + tid] = lb;
    __syncthreads();
#pragma unroll 4
    for (int it = 0; it < 16; ++it) { const int idx = it * 512 + tid, c = idx >> 4, g = idx & 15;
        unsigned char* ap = shm + c * 256 + ((g ^ sgu_swz(c)) << 4);
        const u32x4 raw = *(const u32x4*)ap;
        const float gam = st[c], bet = st[512 + c];
        const f32x4 m0 = *(const f32x4*)(mr + g * 8), m1 = *(const f32x4*)(mr + g * 8 + 4), r0 = *(const f32x4*)(mr + 128 + g * 8), r1 = *(const f32x4*)(mr + 128 + g * 8 + 4);
        u32x4 o;
        o[0] = cvt_pk_bf16((bf_lo(raw[0]) - m0[0]) * r0[0] * gam + bet, (bf_hi(raw[0]) - m0[1]) * r0[1] * gam + bet);
        o[1] = cvt_pk_bf16((bf_lo(raw[1]) - m0[2]) * r0[2] * gam + bet, (bf_hi(raw[1]) - m0[3]) * r0[3] * gam + bet);
        o[2] = cvt_pk_bf16((bf_lo(raw[2]) - m1[0]) * r1[0] * gam + bet, (bf_hi(raw[2]) - m1[1]) * r1[1] * gam + bet);
        o[3] = cvt_pk_bf16((bf_lo(raw[3]) - m1[2]) * r1[2] * gam + bet, (bf_hi(raw[3]) - m1[3]) * r1[3] * gam + bet);
        *(u32x4*)ap = o; }
    __syncthreads();
    {
        const int arow = c0 + (fr >> 2) * 16 + (fr & 3);
        bf16x8 b[2][4][2];
#pragma unroll
        for (int kk = 0; kk < 4; ++kk)
#pragma unroll
            for (int pt = 0; pt < 2; ++pt) b[0][kk][pt] = *(const bf16x8*)(WSS + (size_t)(h * 128 + pt * 16 + fr) * 128 + kk * 32 + fq * 8);
#pragma unroll
        for (int ph = 0; ph < 4; ++ph) {
            if (ph < 3) {
#pragma unroll
                for (int kk = 0; kk < 4; ++kk)
#pragma unroll
                    for (int pt = 0; pt < 2; ++pt) b[(ph + 1) & 1][kk][pt] = *(const bf16x8*)(WSS + (size_t)(h * 128 + (ph + 1) * 32 + pt * 16 + fr) * 128 + kk * 32 + fq * 8);
            }
            f32x4 acc[4][2];
#pragma unroll
            for (int ct = 0; ct < 4; ++ct)
#pragma unroll
                for (int pt = 0; pt < 2; ++pt) acc[ct][pt] = (f32x4){0.f, 0.f, 0.f, 0.f};
#pragma unroll
            for (int kk = 0; kk < 4; ++kk) {
                bf16x8 a[4];
#pragma unroll
                for (int ct = 0; ct < 4; ++ct) { const int row = arow + ct * 4; a[ct] = *(const bf16x8*)(shm + row * 256 + (((kk * 4 + fq) ^ sgu_swz(row)) << 4)); }
#pragma unroll
                for (int ct = 0; ct < 4; ++ct)
#pragma unroll
                    for (int pt = 0; pt < 2; ++pt) acc[ct][pt] = __builtin_amdgcn_mfma_f32_16x16x32_bf16(a[ct], b[ph & 1][kk][pt], acc[ct][pt], 0, 0, 0);
            }
#pragma unroll
            for (int pt = 0; pt < 2; ++pt) {
                const int pp = ph * 32 + pt * 16 + fr; const size_t token = (size_t)t0 + pp; const float bias = p.b_s[h * 128 + pp];
                u32x4 o[2];
#pragma unroll
                for (int hh = 0; hh < 2; ++hh)
#pragma unroll
                    for (int k2 = 0; k2 < 4; ++k2) {
                        const int ct = 2 * hh + (k2 >> 1), j = 2 * (k2 & 1);
                        const unsigned uw = uu[ph][pt][hh][k2];
                        const float o0 = (acc[ct][pt][j] + bias) * bf_lo(uw);
                        const float o1 = (acc[ct][pt][j + 1] + bias) * bf_hi(uw);
                        o[hh][k2] = cvt_pk_bf16(o0, o1); }
                bf16_t* yp = YB + token * 512 + c0 + fq * 16;
                *(u32x4*)yp = o[0]; *(u32x4*)(yp + 8) = o[1];
            }
        }
    }
    __syncthreads();
}

#define XB_TMO      128
#define XB_XCNT(j)  (256  + 64 * (j))
#define XB_XSUB(j)  (1280 + 64 * (j))
#define XB_XGEN(j)  (2304 + 64 * (j))
#define XB_TOP      3328
#define XB_TOPGEN   3392
#define XB_SPIN_CAP (1u << 18)
__device__ __forceinline__ unsigned xb_ld(unsigned* p)              { return __hip_atomic_load(p, __ATOMIC_RELAXED, __HIP_MEMORY_SCOPE_AGENT); }
__device__ __forceinline__ unsigned xb_add(unsigned* p, unsigned v) { return __hip_atomic_fetch_add(p, v, __ATOMIC_RELAXED, __HIP_MEMORY_SCOPE_AGENT); }
__device__ __forceinline__ unsigned xb_xcc_id() { return (unsigned)__builtin_amdgcn_s_getreg((3 << 11) | 20) & 0xFu; }
#define XB_SPIN(cond, bar) do { unsigned _sp = 0; while (cond) { __builtin_amdgcn_s_sleep(1); \
    if ((++_sp & 255u) == 0u) { if (xb_ld(&(bar)[XB_TMO])) break; if (_sp > XB_SPIN_CAP) { atomicAdd(&(bar)[XB_TMO], 1u); break; } } } } while (0)
struct XcdBarrier { unsigned* bar; unsigned x; volatile LAS unsigned* st; };
__device__ __forceinline__ XcdBarrier xcd_barrier_post(unsigned* bar, volatile LAS unsigned* st) {
    XcdBarrier b; b.bar = bar; b.x = xb_xcc_id(); b.st = st;
    if (threadIdx.x == 0) (void)xb_add(&bar[XB_XCNT(b.x)], 1u);
    return b;
}
__device__ __forceinline__ void xcd_barrier_complete(unsigned* bar, unsigned x, unsigned& nloc, unsigned& nx) {
    const unsigned G = gridDim.x * gridDim.y * gridDim.z;
    unsigned sum, cnt, mine, sp = 0u;
    for (;;) {
        sum = 0u; cnt = 0u; mine = 0u;
#pragma unroll
        for (unsigned j = 0; j < 16; ++j) { const unsigned c = xb_ld(&bar[XB_XCNT(j)]); sum += c; cnt += (c > 0u) ? 1u : 0u; mine = (j == x) ? c : mine; }
        if (sum == G) break;
        __builtin_amdgcn_s_sleep(1);
        if ((++sp & 255u) == 0u) { if (xb_ld(&bar[XB_TMO])) break; if (sp > XB_SPIN_CAP) { atomicAdd(&bar[XB_TMO], 1u); break; } }
    }
    nloc = mine > 0u ? mine : 1u; nx = cnt > 0u ? cnt : 1u;
}
__device__ __forceinline__ void xcd_barrier(const XcdBarrier& b) {
    asm volatile("s_waitcnt vmcnt(0)" ::: "memory");
    __syncthreads();
    if (threadIdx.x == 0) {
        unsigned* bar = b.bar;
        __builtin_amdgcn_s_waitcnt(0);
        unsigned nloc = b.st[0], nx = b.st[1];
        if (nloc == 0u) { xcd_barrier_complete(bar, b.x, nloc, nx); b.st[0] = nloc; b.st[1] = nx; }
        const unsigned old = xb_add(&bar[XB_XSUB(b.x)], 1u);
        const unsigned gen = old / nloc;
        if (old + 1u == (gen + 1u) * nloc) {
            __builtin_amdgcn_fence(__ATOMIC_RELEASE, "agent");
            asm volatile("s_waitcnt vmcnt(0)" ::: "memory");
            const unsigned og = xb_add(&bar[XB_TOP], 1u);
            const unsigned tg = og / nx;
            if (og + 1u == (tg + 1u) * nx) xb_add(&bar[XB_TOPGEN], 1u);
            else XB_SPIN(xb_ld(&bar[XB_TOPGEN]) == tg, bar);
            __builtin_amdgcn_fence(__ATOMIC_ACQUIRE, "agent");
            xb_add(&bar[XB_XGEN(b.x)], 1u);
            asm volatile("s_waitcnt vmcnt(0)" ::: "memory");
        } else {
            XB_SPIN(xb_ld(&bar[XB_XGEN(b.x)]) == gen, bar);
            __builtin_amdgcn_fence(__ATOMIC_ACQUIRE, "agent");
            asm volatile("s_waitcnt vmcnt(0)" ::: "memory");
        }
    }
    __syncthreads();
}

__global__ void __launch_bounds__(512, 2) fwd_megakernel(Params p) {
    extern __shared__ __attribute__((aligned(16))) unsigned char shm[];
    cg::grid_group grid = cg::this_grid();
    LAS unsigned char* lds = (LAS unsigned char*)shm;
    unsigned char* ws = p.ws; unsigned char* ob = (unsigned char*)p.out;
    const int G = gridDim.x, c = blockIdx.x;
    volatile LAS unsigned* bst = (volatile LAS unsigned*)(lds + LDS_BYTES - 16);
    if (threadIdx.x == 0) { bst[0] = 0u; bst[1] = 0u; }
    __syncthreads();
    const XcdBarrier xb = xcd_barrier_post((unsigned*)(ws + OFF_BAR), bst);
    if (p.ws == nullptr) grid.sync();
    const int vc = (G % 8 == 0) ? (c % 8) * (G / 8) + c / 8 : c;

    phase0(p, shm);
    xcd_barrier(xb);
    phase1(p, shm);
    xcd_barrier(xb);
    {
        SchedG1 S; S.H = (const char*)(ob + OUT_H); S.WT1 = (const char*)(ws + OFF_WT1); S.G = G; S.c = c;
        EpiG1 E; E.ZR1 = (bf16_t*)(ws + OFF_ZR1); E.ZR2 = (bf16_t*)(ws + OFF_ZR2); E.PTp = (bf16_t*)(ob + OUT_PT); E.PTs = (bf16_t*)(ob + OUT_PTS); E.VT = (bf16_t*)(ws + OFF_VT);
        pg8::gemm_phase<EpiG1, SchedG1>(lds, 1024, S, E);
    }
    xcd_barrier(xb);
    dft_stage1(p, shm);
    xcd_barrier(xb);
    {
        SchedD2 S; S.D2 = (const char*)(ws + OFF_D2); S.X1T = (const char*)(ws + OFF_X1T); S.G = G; S.c = c;
        EpiD2 E; E.ZR1 = (const bf16_t*)(ws + OFF_ZR1); E.YA = (bf16_t*)(ob + OUT_YA); E.b_fmix = p.b_fmix;
        if (c < 128) sgu_chunk(p, shm, c);
        pg8::gemm_phase<EpiD2, SchedD2>(lds, 1024, S, E);
        __syncthreads();
        if (c >= 128) for (int j = 0; j < 2; ++j) sgu_chunk(p, shm, 128 + (c - 128) * 2 + j);
    }
    xcd_barrier(xb);
    {
        SchedG2 S; S.YA = (const char*)(ob + OUT_YA); S.YB = (const char*)(ob + OUT_YB); S.WPA = (const char*)(ws + OFF_WPA); S.WPB = (const char*)(ws + OFF_WPB); S.G = G; S.c = c;
        EpiG2 E; E.ZR2 = (const bf16_t*)(ws + OFF_ZR2); E.MG = (bf16_t*)(ws + OFF_ZR1);
        pg8::gemm_phase<EpiG2, SchedG2>(lds, 512, S, E);
    }
    xcd_barrier(xb);
    {
        SchedG3 S; S.MG = (const char*)(ws + OFF_ZR1); S.WOUT = (const char*)(ws + OFF_WOUT); S.G = G; S.c = c;
        EpiG3 E; E.x_p = p.x_p; E.x_s = p.x_s; E.GATE = (const float*)(ws + OFF_GATE); E.final_g = p.final_g; E.out = p.out; E.GRN = (unsigned long long*)(ws + OFF_GRN);
        pg8::gemm_phase<EpiG3, SchedG3>(lds, 1024, S, E);
    }
}

extern "C" void kernel_launch(void* const* d_in, const int* in_sizes, int n_in, void* d_out, int out_size, void* d_ws, size_t ws_size, hipStream_t stream) {
    static int grid = 0;
    if (grid == 0) {
        if (n_in != 18 || out_size != NTOK * D || ws_size < WS_END) { fprintf(stderr, "kernel_launch: unexpected shapes (n_in %d out %d ws %zu need %zu)\n", n_in, out_size, ws_size, (size_t)WS_END); grid = -1; return; }
        int dev = 0, cus = 0, per_cu = 0;
        hipGetDevice(&dev);
        hipDeviceGetAttribute(&cus, hipDeviceAttributeMultiprocessorCount, dev);
        if (hipFuncSetAttribute((const void*)fwd_megakernel, hipFuncAttributeMaxDynamicSharedMemorySize, LDS_BYTES) != hipSuccess) { fprintf(stderr, "kernel_launch: hipFuncSetAttribute failed\n"); grid = -1; return; }
        if (hipOccupancyMaxActiveBlocksPerMultiprocessor(&per_cu, (const void*)fwd_megakernel, 512, LDS_BYTES) != hipSuccess || per_cu < 1) { fprintf(stderr, "kernel_launch: occupancy query gave %d\n", per_cu); per_cu = 1; }
        (void)hipGetLastError();
        grid = cus * per_cu;
        if (grid != 256) { fprintf(stderr, "kernel_launch: this build needs a 256-workgroup cooperative grid, got %d\n", grid); grid = -1; return; }
        fprintf(stderr, "kernel_launch: grid %d (cus %d x %d)\n", grid, cus, per_cu);
    }
    if (grid < 0) return;
    Params p{};
    p.x_p = (const float*)d_in[0]; p.x_s = (const float*)d_in[1]; p.c_p = (const float*)d_in[2]; p.c_s = (const float*)d_in[3];
    p.norm_g = (const float*)d_in[4]; p.w_ada = (const float*)d_in[5]; p.b_ada = (const float*)d_in[6]; p.w_in = (const float*)d_in[7];
    p.w_fmix = (const float*)d_in[8]; p.b_fmix = (const float*)d_in[9]; p.ln_g = (const float*)d_in[10]; p.ln_b = (const float*)d_in[11];
    p.w_s = (const float*)d_in[12]; p.b_s = (const float*)d_in[13]; p.w_pa = (const float*)d_in[14]; p.w_pb = (const float*)d_in[15];
    p.w_out = (const float*)d_in[16]; p.final_g = (const float*)d_in[17];
    p.out = (float*)d_out; p.ws = (unsigned char*)d_ws;
    if (hipMemsetAsync((unsigned char*)d_ws + OFF_BAR, 0, BAR_BYTES, stream) != hipSuccess) { fprintf(stderr, "kernel_launch: memset of the barrier words failed\n"); return; }
    void* args[] = {&p};
    hipError_t e = hipLaunchCooperativeKernel((const void*)fwd_megakernel, dim3(grid), dim3(512), args, LDS_BYTES, stream);
    if (e != hipSuccess) fprintf(stderr, "kernel_launch: cooperative launch failed: %s (grid %d)\n", hipGetErrorString(e), grid);
}
```

```cpp
#include <hip/hip_runtime.h>
#include <hip/hip_cooperative_groups.h>
#include <cstdio>
namespace cg = cooperative_groups;

#define LAS __attribute__((address_space(3)))
typedef unsigned short bf16_t;
typedef short bf16x8 __attribute__((ext_vector_type(8)));
typedef float f32x4 __attribute__((ext_vector_type(4)));
typedef unsigned u32x4 __attribute__((ext_vector_type(4)));
typedef unsigned u32x2 __attribute__((ext_vector_type(2)));

constexpr int D = 1024;
constexpr int NTOK = 49152, NTOK_P = 32768;
constexpr int SP = 2048, SS = 4096;
constexpr int NB = 20;
constexpr int INW = 4608;
constexpr int LDS_BYTES = 131072 + 8192;

constexpr size_t OFF_MODP = 0;
constexpr size_t OFF_GATE = OFF_MODP + (size_t)8 * 20 * 3072 * 4;
constexpr size_t OFF_WT1  = OFF_GATE + (size_t)20 * 1024 * 4;
constexpr size_t OFF_WPA  = OFF_WT1 + (size_t)5120 * 1024 * 2;
constexpr size_t OFF_WPB  = OFF_WPA + (size_t)1024 * 512 * 2;
constexpr size_t OFF_WOUT = OFF_WPB + (size_t)1024 * 512 * 2;
constexpr size_t OFF_WSS  = OFF_WOUT + (size_t)1024 * 1024 * 2;
constexpr size_t OFF_D2   = OFF_WSS + (size_t)4 * 128 * 128 * 2;
constexpr size_t OFF_X1T  = OFF_D2 + (size_t)512 * 1024 * 2;
constexpr size_t OFF_ZR1  = OFF_X1T + (size_t)NTOK * 1024 * 2;
constexpr size_t OFF_ZR2  = OFF_ZR1 + (size_t)NTOK * 1024 * 2;
constexpr size_t OFF_VT   = OFF_ZR2 + (size_t)NTOK * 2048 * 2;
constexpr size_t OFF_GRN  = OFF_VT + (size_t)512 * NTOK * 2;
constexpr size_t GRN_WORDS = (size_t)192 * 4 * 4 * 256;
constexpr size_t OFF_BAR  = OFF_GRN + GRN_WORDS * 8;
constexpr size_t BAR_BYTES = 3456 * 4;
constexpr size_t WS_END   = OFF_BAR + BAR_BYTES;
constexpr size_t OUT_H  = 0;
constexpr size_t OUT_PT = (size_t)NTOK * 1024 * 2;
constexpr size_t OUT_PTS = OUT_PT + (size_t)16 * 512 * 2 * 2048 * 2;
constexpr size_t OUT_YA = 0;
constexpr size_t OUT_YB = (size_t)NTOK * 512 * 2;

struct Params {
    const float *x_p, *x_s, *c_p, *c_s, *norm_g, *w_ada, *b_ada, *w_in, *w_fmix, *b_fmix, *ln_g, *ln_b, *w_s, *b_s, *w_pa, *w_pb, *w_out, *final_g;
    float* out; unsigned char* ws;
};

#define TABI(i) ((i) + ((i) >> 5))
__device__ __forceinline__ int opaque_tid() { int t = threadIdx.x; asm volatile("" : "+v"(t)); return t; }
typedef __bf16 bf16x2_t __attribute__((ext_vector_type(2)));
typedef float f32x2_t __attribute__((ext_vector_type(2)));
__device__ __forceinline__ unsigned cvt_pk_bf16(float lo, float hi) { const f32x2_t v = {lo, hi}; return __builtin_bit_cast(unsigned, __builtin_convertvector(v, bf16x2_t)); }
__device__ __forceinline__ float bf_lo(unsigned w) { return __uint_as_float(w << 16); }
__device__ __forceinline__ float bf_hi(unsigned w) { return __uint_as_float(w & 0xffff0000u); }
__device__ __forceinline__ float sigm(float x) { return __builtin_amdgcn_rcpf(1.f + __builtin_amdgcn_exp2f(x * -1.4426950408889634f)); }
__device__ __forceinline__ float silu(float x) { return x * sigm(x); }
__device__ __forceinline__ float wave_sum(float v) {
#pragma unroll
    for (int o = 32; o > 0; o >>= 1) v += __shfl_xor(v, o, 64);
    return v;
}
__device__ __forceinline__ const float* xrow(const Params& p, int token) {
    return token < NTOK_P ? p.x_p + (size_t)token * D : p.x_s + (size_t)(token - NTOK_P) * D;
}
__device__ __forceinline__ int batch_of(int token) { return token < NTOK_P ? (token >> 11) : 16 + ((token - NTOK_P) >> 12); }

namespace pg8 {
constexpr int BM = 256, BK = 64, HALF = 128, HTB = HALF * BK * 2, NXCD = 8, WGM = 8;
__device__ __forceinline__ int lds_byte(int r, int c) { const int st = (r >> 4) * 2 + (c >> 5), rr = r & 15, cc = c & 31, ob = rr * 64 + cc * 2; return st * 1024 + (ob ^ (((ob >> 9) & 1) << 5)); }
__device__ __forceinline__ void stage_rc(int b, int& R, int& C) { const int st = b / 1024, sb = b % 1024, swz = sb ^ (((sb >> 9) & 1) << 5); R = (st >> 1) * 16 + swz / 64; C = (st & 1) * 32 + (swz % 64) / 2; }
__device__ __forceinline__ int perm32(int rho) { const int n = rho >> 4, i = rho & 15; return 8 * (i >> 2) + 4 * n + (i & 3); }

struct Unit { const char* A; const char* B; int pm, pn, kind, pad; };

__device__ __forceinline__ void tile_map(int L, int nM, int nN, int& pm, int& pn) {
    const int nwg = nM * nN; int wgid = L;
    { const int q = nwg / NXCD, r = nwg % NXCD, xcd = wgid % NXCD, off = wgid / NXCD; wgid = (xcd < r ? xcd * (q + 1) : r * (q + 1) + (xcd - r) * q) + off; }
    const int nig = WGM * nN, gid = wgid / nig, fm = gid * WGM, gsz = (nM - fm) < WGM ? (nM - fm) : WGM;
    pm = fm + ((wgid % nig) % gsz); pn = (wgid % nig) / gsz;
}

template <class Epi, class Sched>
__device__ __forceinline__ void gemm_phase(LAS unsigned char* lds, const int K, const Sched& S, const Epi& E) {
    const int tid = opaque_tid(), wid = __builtin_amdgcn_readfirstlane(tid >> 6), lane = tid & 63, wr = wid >> 2, wc = wid & 3, fr = lane & 15, fq = lane >> 4;
    const int nt = K / BK;
    unsigned voffA[2], voffB[2];
#pragma unroll
    for (int i = 0; i < 2; ++i) { int R, C; stage_rc(tid * 16 + i * 8192, R, C); const int Rb = Epi::PERM ? ((R & ~31) + perm32(R & 31)) : R;
        voffA[i] = (unsigned)(R * K + C) * 2u; voffB[i] = (unsigned)(Rb * K + C) * 2u; }
    const size_t kstep = (size_t)(BK * 2);
    const size_t hstep = (size_t)HALF * K * 2;
    const unsigned ldsw = (unsigned)wid * 1024u;
    const int aoff = lds_byte(wr * 64 + fr, fq * 8), boff = lds_byte(wc * 32 + fr, fq * 8);
#define PG8_SA(b, h) (((b) * 2 + (h)) * HTB)
#define PG8_SB(b, h) ((4 + (b) * 2 + (h)) * HTB)
#define PG8_STAGE(bufoff, gbase, voff) do { _Pragma("unroll") for (int _i = 0; _i < 2; ++_i) \
        __builtin_amdgcn_global_load_lds((const unsigned*)((const char*)(gbase) + (voff)[_i]), (LAS unsigned*)(lds + (bufoff) + ldsw + _i * 8192), 16, 0, 0); } while (0)
#define PG8_LDA(dst, b, h) do { _Pragma("unroll") for (int m = 0; m < 4; ++m) _Pragma("unroll") for (int k = 0; k < 2; ++k) dst[m][k] = *(const LAS bf16x8*)(lds + PG8_SA(b, h) + aoff + m * 2048 + k * 1024); } while (0)
#define PG8_LDB(dst, b, h) do { _Pragma("unroll") for (int n = 0; n < 2; ++n) _Pragma("unroll") for (int k = 0; k < 2; ++k) dst[n][k] = *(const LAS bf16x8*)(lds + PG8_SB(b, h) + boff + n * 2048 + k * 1024); } while (0)
#define PG8_MMA(ai, bj, At, Bt) do { __builtin_amdgcn_s_setprio(1); _Pragma("unroll") for (int m = 0; m < 4; ++m) _Pragma("unroll") for (int n = 0; n < 2; ++n) _Pragma("unroll") for (int k = 0; k < 2; ++k) \
        acc[ai][bj][m][n] = __builtin_amdgcn_mfma_f32_16x16x32_bf16(Bt[n][k], At[m][k], acc[ai][bj][m][n], 0, 0, 0); __builtin_amdgcn_s_setprio(0); } while (0)
#define PG8_WAIT_V(n) asm volatile("s_waitcnt vmcnt(" #n ")" ::: "memory")
#define PG8_WAIT_L(n) asm volatile("s_waitcnt lgkmcnt(" #n ")" ::: "memory")
#define PG8_BAR __builtin_amdgcn_s_barrier()
#define PG8_SCHED __builtin_amdgcn_sched_barrier(0)
    Unit cur, nxt; int ui = 0;
    if (!S.next(0, cur)) return;
    f32x4 acc[2][2][4][2];
#pragma unroll
    for (int a = 0; a < 2; ++a)
#pragma unroll
        for (int b = 0; b < 2; ++b)
#pragma unroll
            for (int m = 0; m < 4; ++m)
#pragma unroll
                for (int n = 0; n < 2; ++n) acc[a][b][m][n] = (f32x4){0.f, 0.f, 0.f, 0.f};
    bf16x8 At[4][2], B0[2][2], B1[2][2];
    const char* cA = cur.A; const char* cB = cur.B;
    PG8_STAGE(PG8_SB(0, 0), cB, voffB); PG8_STAGE(PG8_SA(0, 0), cA, voffA); PG8_STAGE(PG8_SB(0, 1), cB + hstep, voffB); PG8_STAGE(PG8_SA(0, 1), cA + hstep, voffA);
    if (wr == 1) PG8_BAR;
    PG8_WAIT_V(4); PG8_BAR;
    PG8_STAGE(PG8_SB(1, 0), cB + kstep, voffB); PG8_STAGE(PG8_SA(1, 0), cA + kstep, voffA); PG8_STAGE(PG8_SB(1, 1), cB + hstep + kstep, voffB);
    PG8_WAIT_V(6); PG8_BAR;
    for (;;) {
        const bool has_next = S.next(ui + 1, nxt);
        const char* nA = has_next ? nxt.A : cA; const char* nB = has_next ? nxt.B : cB;
        for (int t = 0; t < nt; t += 2) {
            const bool last = (t == nt - 2);
            const char* a1 = cA + (size_t)(t + 1) * kstep;
            const char* a2 = last ? nA : cA + (size_t)(t + 2) * kstep; const char* b2 = last ? nB : cB + (size_t)(t + 2) * kstep;
            const char* a3 = a2 + kstep; const char* b3 = b2 + kstep;
            PG8_LDB(B0, 0, 0); PG8_SCHED; PG8_LDA(At, 0, 0); PG8_STAGE(PG8_SA(1, 1), a1 + hstep, voffA);
            PG8_WAIT_L(8); PG8_BAR; PG8_WAIT_L(0); PG8_MMA(0, 0, At, B0); PG8_BAR; PG8_SCHED;
            PG8_LDB(B1, 0, 1); PG8_STAGE(PG8_SB(0, 0), b2, voffB);
            PG8_BAR; PG8_WAIT_L(0); PG8_MMA(0, 1, At, B1); PG8_BAR;
            PG8_LDA(At, 0, 1); PG8_STAGE(PG8_SA(0, 0), a2, voffA);
            PG8_BAR; PG8_WAIT_L(0); PG8_MMA(1, 0, At, B0); PG8_BAR; PG8_SCHED;
            PG8_STAGE(PG8_SB(0, 1), b2 + hstep, voffB);
            PG8_WAIT_V(6); PG8_BAR; PG8_MMA(1, 1, At, B1); PG8_BAR;
            PG8_LDB(B0, 1, 0); PG8_SCHED; PG8_LDA(At, 1, 0); PG8_STAGE(PG8_SA(0, 1), a2 + hstep, voffA);
            PG8_WAIT_L(8); PG8_BAR; PG8_WAIT_L(0); PG8_MMA(0, 0, At, B0); PG8_BAR; PG8_SCHED;
            PG8_LDB(B1, 1, 1); PG8_STAGE(PG8_SB(1, 0), b3, voffB);
            PG8_BAR; PG8_WAIT_L(0); PG8_MMA(0, 1, At, B1); PG8_BAR;
            PG8_LDA(At, 1, 1); PG8_STAGE(PG8_SA(1, 0), a3, voffA);
            PG8_BAR; PG8_WAIT_L(0); PG8_MMA(1, 0, At, B0); PG8_BAR; PG8_SCHED;
            PG8_STAGE(PG8_SB(1, 1), b3 + hstep, voffB);
            PG8_WAIT_V(6); PG8_BAR; PG8_MMA(1, 1, At, B1); PG8_BAR;
        }
        E(acc, cur, wr, wc, fr, fq);
        if (!has_next) break;
        if (!Epi::OWN_ACC && !(cur.kind & 1)) {
#pragma unroll
            for (int a = 0; a < 2; ++a)
#pragma unroll
                for (int b = 0; b < 2; ++b)
#pragma unroll
                    for (int m = 0; m < 4; ++m)
#pragma unroll
                        for (int n = 0; n < 2; ++n) acc[a][b][m][n] = (f32x4){0.f, 0.f, 0.f, 0.f};
        }
        cur = nxt; cA = nA; cB = nB; ++ui;
    }
    PG8_WAIT_V(0);
    if (wr == 0) PG8_BAR;
    PG8_BAR;
#undef PG8_SA
#undef PG8_SB
#undef PG8_STAGE
#undef PG8_LDA
#undef PG8_LDB
#undef PG8_MMA
#undef PG8_WAIT_V
#undef PG8_WAIT_L
#undef PG8_BAR
#undef PG8_SCHED
}
}
using pg8::Unit;

__device__ __forceinline__ u32x4 pack8(const f32x4& a, const f32x4& b) {
    u32x4 o; o[0] = cvt_pk_bf16(a[0], a[1]); o[1] = cvt_pk_bf16(a[2], a[3]); o[2] = cvt_pk_bf16(b[0], b[1]); o[3] = cvt_pk_bf16(b[2], b[3]); return o;
}

struct SchedG1 {
    const char* H; const char* WT1; int G, c;
    __device__ __forceinline__ bool next(int i, Unit& u) const {
        const long L = (long)i * G + c;
        if (L < 2688) { int pm, pn; pg8::tile_map((int)L, 192, 14, pm, pn); u.pm = pm; u.pn = pn; u.kind = 0; u.pad = 0;
            u.A = H + (size_t)pm * 256 * 1024 * 2; u.B = WT1 + (size_t)(1536 + pn * 256) * 1024 * 2; return true; }
        if (L < 3840) { int pm, pn; pg8::tile_map((int)(L - 2688), 6, 192, pm, pn); u.pm = pm; u.pn = pn; u.kind = 2; u.pad = 0;
            u.A = WT1 + (size_t)pm * 256 * 1024 * 2; u.B = H + (size_t)pn * 256 * 1024 * 2; return true; }
        return false;
    }
};
struct EpiG1 {
    static constexpr bool OWN_ACC = false;
    static constexpr bool PERM = true;
    bf16_t *ZR1, *ZR2, *PTp, *PTs, *VT;
    __device__ __forceinline__ void operator()(f32x4 (&acc)[2][2][4][2], const Unit& u, int wr, int wc, int fr_, int fq_) const {
        int fr = fr_, fq = fq_; asm volatile("" : "+v"(fr), "+v"(fq));
        if (u.kind == 0 && u.pn < 2) {
            bf16_t* base = ZR1 + u.pn * 256;
            const int row0 = u.pm * 256 + wr * 64 + fr, col0 = wc * 32 + 8 * fq;
#pragma unroll
            for (int ai = 0; ai < 2; ++ai)
#pragma unroll
                for (int m = 0; m < 4; ++m) { bf16_t* rowp = base + (size_t)(row0 + ai * 128 + m * 16) * 1024 + col0;
#pragma unroll
                    for (int bj = 0; bj < 2; ++bj) *(u32x4*)(rowp + bj * 128) = pack8(acc[ai][bj][m][0], acc[ai][bj][m][1]); }
        } else if (u.kind == 0 && u.pn < 6) {
            const int row0 = u.pm * 256 + wr * 64 + fr, col0 = 512 + (u.pn - 2) * 128 + wc * 32 + 8 * fq;
#pragma unroll
            for (int ai = 0; ai < 2; ++ai)
#pragma unroll
                for (int m = 0; m < 4; ++m) { f32x4 o0, o1;
#pragma unroll
                    for (int q = 0; q < 4; ++q) { o0[q] = acc[ai][0][m][0][q] * silu(acc[ai][1][m][0][q]); o1[q] = acc[ai][0][m][1][q] * silu(acc[ai][1][m][1][q]); }
                    *(u32x4*)(ZR1 + (size_t)(row0 + ai * 128 + m * 16) * 1024 + col0) = pack8(o0, o1); }
        } else if (u.kind == 0) {
            const int row0 = u.pm * 256 + wr * 64 + fr, col0 = (u.pn - 6) * 128 + wc * 32 + 8 * fq;
#pragma unroll
            for (int ai = 0; ai < 2; ++ai)
#pragma unroll
                for (int m = 0; m < 4; ++m) { bf16_t* rowp = ZR2 + (size_t)(row0 + ai * 128 + m * 16) * 2048 + col0;
                    f32x4 r0, r1, s0, s1;
#pragma unroll
                    for (int q = 0; q < 4; ++q) {
                        const float ea0 = __builtin_amdgcn_exp2f(acc[ai][0][m][0][q] * -1.4426950408889634f), ea1 = __builtin_amdgcn_exp2f(acc[ai][0][m][1][q] * -1.4426950408889634f);
                        const float eb0 = __builtin_amdgcn_exp2f(acc[ai][1][m][0][q] * -1.4426950408889634f), eb1 = __builtin_amdgcn_exp2f(acc[ai][1][m][1][q] * -1.4426950408889634f);
                        const float pa0 = 1.f + ea0, pb0 = 1.f + eb0, pa1 = 1.f + ea1, pb1 = 1.f + eb1;
                        const float t0 = __builtin_amdgcn_rcpf(pa0 * pb0), t1 = __builtin_amdgcn_rcpf(pa1 * pb1);
                        s0[q] = pa0 * t0; s1[q] = pa1 * t1; r0[q] = pb0 * pb0 * t0; r1[q] = pb1 * pb1 * t1; }
                    __builtin_nontemporal_store(pack8(r0, r1), (u32x4*)rowp); __builtin_nontemporal_store(pack8(s0, s1), (u32x4*)(rowp + 1024)); }
        } else {
#pragma unroll
            for (int bj = 0; bj < 2; ++bj) {
                const int t = u.pn * 256 + bj * 128 + wc * 32 + 8 * fq;
                bf16_t* base; size_t colstride, partstride;
                if (t < NTOK_P) { const int b = t >> 11, s = t & 2047; base = PTp + (size_t)b * 512 * 4096 + s; colstride = 4096; partstride = 2048; }
                else { const int tt = t - NTOK_P, b = tt >> 12, s = tt & 4095; base = PTs + (size_t)b * 512 * 4096 + s; colstride = 4096; partstride = (size_t)4 * 512 * 4096; }
#pragma unroll
                for (int ai = 0; ai < 2; ++ai)
#pragma unroll
                    for (int m = 0; m < 4; ++m) { const int r = u.pm * 256 + ai * 128 + wr * 64 + m * 16 + fr, part = r >> 9, col = r & 511;
                        bf16_t* dst = (u.pm < 4) ? base + (size_t)col * colstride + (size_t)part * partstride : VT + (size_t)col * NTOK + t;
                        *(u32x4*)dst = pack8(acc[ai][bj][m][0], acc[ai][bj][m][1]); }
            }
        }
    }
};

struct SchedD2 {
    const char *D2, *X1T; int G, c;
    __device__ __forceinline__ bool next(int i, Unit& u) const {
        const long L = (long)i * G + c;
        if (L >= 384) return false;
        u.pm = (int)L & 1; u.pn = (int)L >> 1; u.kind = 0; u.pad = 0;
        u.A = D2 + (size_t)u.pm * 256 * 1024 * 2; u.B = X1T + (size_t)u.pn * 256 * 1024 * 2; return true;
    }
};
struct EpiD2 {
    static constexpr bool OWN_ACC = false;
    static constexpr bool PERM = true;
    const bf16_t* ZR1; bf16_t* YA; const float* b_fmix;
    __device__ __forceinline__ void operator()(f32x4 (&acc)[2][2][4][2], const Unit& u, int wr, int wc, int fr_, int fq_) const {
        int fr = fr_, fq = fq_; asm volatile("" : "+v"(fr), "+v"(fq));
#pragma unroll
        for (int bj = 0; bj < 2; ++bj) {
            const int n = u.pn * 256 + bj * 128 + wc * 32 + 8 * fq, col = n & 511;
            int k1, tokb, n1;
            if (n < 32768) { k1 = n >> 13; tokb = ((n >> 9) & 15) * SP; n1 = 4; }
            else { const int nn = n - 32768; k1 = nn >> 11; tokb = NTOK_P + ((nn >> 9) & 3) * SS; n1 = 8; }
            const f32x4 bv0 = *(const f32x4*)(b_fmix + col), bv1 = *(const f32x4*)(b_fmix + col + 4);
            u32x4 gv[2][4];
#pragma unroll
            for (int ai = 0; ai < 2; ++ai)
#pragma unroll
                for (int m = 0; m < 4; ++m) { const int k2 = u.pm * 256 + ai * 128 + wr * 64 + m * 16 + fr; gv[ai][m] = __builtin_nontemporal_load((const u32x4*)(ZR1 + (size_t)(tokb + k1 + n1 * k2) * 1024 + col)); }
#pragma unroll
            for (int ai = 0; ai < 2; ++ai)
#pragma unroll
                for (int m = 0; m < 4; ++m) { const int k2 = u.pm * 256 + ai * 128 + wr * 64 + m * 16 + fr; const size_t token = (size_t)(tokb + k1 + n1 * k2);
                    const u32x4 g = gv[ai][m];
                    f32x4 v0 = acc[ai][bj][m][0] + bv0, v1 = acc[ai][bj][m][1] + bv1;
                    v0[0] *= silu(bf_lo(g[0])); v0[1] *= silu(bf_hi(g[0])); v0[2] *= silu(bf_lo(g[1])); v0[3] *= silu(bf_hi(g[1]));
                    v1[0] *= silu(bf_lo(g[2])); v1[1] *= silu(bf_hi(g[2])); v1[2] *= silu(bf_lo(g[3])); v1[3] *= silu(bf_hi(g[3]));
                    *(u32x4*)(YA + token * 512 + col) = pack8(v0, v1); }
        }
    }
};

template <int W8> __device__ __forceinline__ void cmac8(float& xr, float& xi, float zr, float zi) {
    constexpr float R = 0.70710678118654752f;
    if (W8 == 0) { xr += zr; xi += zi; }
    else if (W8 == 1) { xr += R * (zr + zi); xi += R * (zi - zr); }
    else if (W8 == 2) { xr += zi; xi -= zr; }
    else if (W8 == 3) { xr += R * (zi - zr); xi -= R * (zi + zr); }
    else if (W8 == 4) { xr -= zr; xi -= zi; }
    else if (W8 == 5) { xr -= R * (zr + zi); xi += R * (zr - zi); }
    else if (W8 == 6) { xr -= zi; xi += zr; }
    else { xr += R * (zr - zi); xi += R * (zr + zi); }
}
template <int N1, int NP, int K1, int S1> struct DftAcc {
    static __device__ __forceinline__ void run(float (&xr)[NP], float (&xi)[NP], const float (&zr)[N1][NP], const float (&zi)[N1][NP]) {
#pragma unroll
        for (int j = 0; j < NP; ++j) cmac8<((K1 * S1) % N1) * (8 / N1)>(xr[j], xi[j], zr[S1][j], zi[S1][j]);
        if constexpr (S1 + 1 < N1) DftAcc<N1, NP, K1, S1 + 1>::run(xr, xi, zr, zi);
    }
};
template <int N1, int NP, int K1> struct DftK {
    static __device__ __forceinline__ void run(const float (&zr)[N1][NP], const float (&zi)[N1][NP], const float* tab, int s20, float scale, bf16_t* dst, size_t k1stride) {
        constexpr int SEQ = N1 * 512;
        float xr[NP], xi[NP];
#pragma unroll
        for (int j = 0; j < NP; ++j) { xr[j] = 0.f; xi[j] = 0.f; }
        DftAcc<N1, NP, K1, 0>::run(xr, xi, zr, zi);
        float yr[NP], yi[NP];
#pragma unroll
        for (int j = 0; j < NP; ++j) { const int ti = ((K1 * (s20 + j)) & (SEQ - 1)) * (4096 / SEQ);
            const float ct = tab[TABI(ti)] * scale, st = tab[TABI((ti - 1024) & 4095)] * scale;
            yr[j] = ct * xr[j] + st * xi[j]; yi[j] = ct * xi[j] - st * xr[j]; }
        bf16_t* d = dst + (size_t)K1 * k1stride;
        if constexpr (NP == 8) { u32x4 o0, o1;
#pragma unroll
            for (int j = 0; j < 4; ++j) { o0[j] = cvt_pk_bf16(yr[2 * j], yr[2 * j + 1]); o1[j] = cvt_pk_bf16(yi[2 * j], yi[2 * j + 1]); }
            *(u32x4*)d = o0; *(u32x4*)(d + 512) = o1;
        } else { u32x2 o0, o1;
#pragma unroll
            for (int j = 0; j < 2; ++j) { o0[j] = cvt_pk_bf16(yr[2 * j], yr[2 * j + 1]); o1[j] = cvt_pk_bf16(yi[2 * j], yi[2 * j + 1]); }
            *(u32x2*)d = o0; *(u32x2*)(d + 512) = o1; }
        if constexpr (K1 + 1 < N1) DftK<N1, NP, K1 + 1>::run(zr, zi, tab, s20, scale, dst, k1stride);
    }
};
template <int N1, int NP> __device__ __forceinline__ void dft1_item(const bf16_t* re, const bf16_t* im, const float* tab, int s20, float scale, bf16_t* dst, size_t k1stride) {
    float zr[N1][NP], zi[N1][NP];
    if constexpr (NP == 8) {
        u32x4 a[N1], b[N1];
#pragma unroll
        for (int s1 = 0; s1 < N1; ++s1) { a[s1] = __builtin_nontemporal_load((const u32x4*)(re + 512 * s1 + s20)); b[s1] = __builtin_nontemporal_load((const u32x4*)(im + 512 * s1 + s20)); }
#pragma unroll
        for (int s1 = 0; s1 < N1; ++s1)
#pragma unroll
            for (int j = 0; j < 4; ++j) { zr[s1][2 * j] = bf_lo(a[s1][j]); zr[s1][2 * j + 1] = bf_hi(a[s1][j]); zi[s1][2 * j] = -bf_lo(b[s1][j]); zi[s1][2 * j + 1] = -bf_hi(b[s1][j]); }
    } else {
        u32x2 a[N1], b[N1];
#pragma unroll
        for (int s1 = 0; s1 < N1; ++s1) { a[s1] = __builtin_nontemporal_load((const u32x2*)(re + 512 * s1 + s20)); b[s1] = __builtin_nontemporal_load((const u32x2*)(im + 512 * s1 + s20)); }
#pragma unroll
        for (int s1 = 0; s1 < N1; ++s1)
#pragma unroll
            for (int j = 0; j < 2; ++j) { zr[s1][2 * j] = bf_lo(a[s1][j]); zr[s1][2 * j + 1] = bf_hi(a[s1][j]); zi[s1][2 * j] = -bf_lo(b[s1][j]); zi[s1][2 * j + 1] = -bf_hi(b[s1][j]); }
    }
    DftK<N1, NP, 0>::run(zr, zi, tab, s20, scale, dst, k1stride);
}
__device__ void dft_stage1(const Params& p, unsigned char* shm) {
    const int tid = opaque_tid();
    float* tab = (float*)shm;
    for (int j = tid; j < 4096; j += 512) tab[TABI(j)] = cospif((float)j * (1.0f / 2048.0f));
    __syncthreads();
    const bf16_t* PTp = (const bf16_t*)((unsigned char*)p.out + OUT_PT); const bf16_t* PTs = (const bf16_t*)((unsigned char*)p.out + OUT_PTS);
    bf16_t* X1T = (bf16_t*)(p.ws + OFF_X1T);
#pragma unroll 1
    for (int it = blockIdx.x * 512 + tid; it < 16 * 512 * 64; it += gridDim.x * 512) {
        const int g = it & 63, col = (it >> 6) & 511, b = it >> 15;
        const bf16_t* re = PTp + (size_t)(b * 512 + col) * 4096;
        dft1_item<4, 8>(re, re + 2048, tab, g * 8, 0.02209708691207961f, X1T + (size_t)(b * 512 + col) * 1024 + g * 8, (size_t)16 * 512 * 1024);
    }
#pragma unroll 1
    for (int it = blockIdx.x * 512 + tid; it < 4 * 512 * 128; it += gridDim.x * 512) {
        const int g = it & 127, col = (it >> 7) & 511, b = it >> 16;
        const bf16_t* re = PTs + (size_t)(b * 512 + col) * 4096;
        dft1_item<8, 4>(re, re + (size_t)4 * 512 * 4096, tab, g * 4, 0.015625f, X1T + (size_t)(32768 + b * 512 + col) * 1024 + g * 4, (size_t)4 * 512 * 1024);
    }
}

struct SchedG2 {
    const char *YA, *YB, *WPA, *WPB; int G, c;
    __device__ __forceinline__ bool next(int i, Unit& u) const {
        const long L = (long)(i >> 1) * G + c; const int sub = i & 1;
        if (L >= 768) return false;
        int pm, pn; pg8::tile_map((int)L, 192, 4, pm, pn); u.pm = pm; u.pn = pn; u.kind = sub ? 0 : 1; u.pad = 0;
        u.A = (sub ? YB : YA) + (size_t)pm * 256 * 512 * 2; u.B = (sub ? WPB : WPA) + (size_t)pn * 256 * 512 * 2; return true;
    }
};
struct EpiG2 {
    static constexpr bool PERM = true, OWN_ACC = true;
    const bf16_t* ZR2; bf16_t* MG;
    __device__ __forceinline__ void operator()(f32x4 (&acc)[2][2][4][2], const Unit& u, int wr, int wc, int fr_, int fq_) const {
        int fr = fr_, fq = fq_; asm volatile("" : "+v"(fr), "+v"(fq));
        const int row0 = u.pm * 256 + wr * 64 + fr, col0 = u.pn * 256 + wc * 32 + 8 * fq;
        const bool keep = (u.kind & 1) != 0;
        const float kf = keep ? 1.f : 0.f;
        const int zoff = keep ? 0 : 1024;
        u32x4 bv[2][4][2];
#pragma unroll
        for (int ai = 0; ai < 2; ++ai)
#pragma unroll
            for (int m = 0; m < 4; ++m)
#pragma unroll
                for (int bj = 0; bj < 2; ++bj) bv[ai][m][bj] = __builtin_nontemporal_load((const u32x4*)(ZR2 + (size_t)(row0 + ai * 128 + m * 16) * 2048 + zoff + col0 + bj * 128));
#pragma unroll
        for (int ai = 0; ai < 2; ++ai) {
#pragma unroll
            for (int m = 0; m < 4; ++m) { const size_t row = (size_t)(row0 + ai * 128 + m * 16);
#pragma unroll
                for (int bj = 0; bj < 2; ++bj) { const u32x4 b = bv[ai][m][bj];
                    f32x4 v0 = acc[ai][bj][m][0], v1 = acc[ai][bj][m][1];
                    v0[0] *= bf_lo(b[0]); v0[1] *= bf_hi(b[0]); v0[2] *= bf_lo(b[1]); v0[3] *= bf_hi(b[1]);
                    v1[0] *= bf_lo(b[2]); v1[1] *= bf_hi(b[2]); v1[2] *= bf_lo(b[3]); v1[3] *= bf_hi(b[3]);
                    if (!keep) *(u32x4*)(MG + row * 1024 + col0 + bj * 128) = pack8(v0, v1);
                    acc[ai][bj][m][0] = v0 * kf; acc[ai][bj][m][1] = v1 * kf; } }
        }
    }
};

struct SchedG3 {
    const char *MG, *WOUT; int G, c;
    __device__ __forceinline__ bool next(int i, Unit& u) const {
        const int q = G >> 2, pn = c / q, pm = i * q + c % q;
        if (pm >= 192) return false;
        u.pm = pm; u.pn = pn; u.kind = 0; u.pad = 0;
        u.A = MG + (size_t)pm * 256 * 1024 * 2; u.B = WOUT + (size_t)pn * 256 * 1024 * 2; return true;
    }
};
typedef __attribute__((address_space(1))) unsigned long long gu64;
struct EpiG3 {     static constexpr bool OWN_ACC = false;
    static constexpr bool PERM = false;
    const float *x_p, *x_s, *GATE, *final_g; float* out; unsigned long long* GRN;
    __device__ __forceinline__ void operator()(f32x4 (&acc)[2][2][4][2], const Unit& u, int wr, int wc, int fr_, int fq_) const {
        int fr = fr_, fq = fq_; asm volatile("" : "+v"(fr), "+v"(fq));
        const int row0 = u.pm * 256 + wr * 64 + fr, col0 = u.pn * 256 + wc * 32 + 4 * fq;
        const int b = batch_of(u.pm * 256);
        float rs[2][4];
        {
            f32x4 gv[2][2];
#pragma unroll
            for (int bj = 0; bj < 2; ++bj)
#pragma unroll
                for (int n = 0; n < 2; ++n) gv[bj][n] = *(const f32x4*)(GATE + b * 1024 + col0 + bj * 128 + n * 16);
#pragma unroll
            for (int ai = 0; ai < 2; ++ai)
#pragma unroll
                for (int m = 0; m < 4; ++m) { const int row = row0 + ai * 128 + m * 16;
                    const float* xr = (row < NTOK_P ? x_p + (size_t)row * D : x_s + (size_t)(row - NTOK_P) * D) + col0;
                    float ss = 0.f;
#pragma unroll
                    for (int bj = 0; bj < 2; ++bj)
#pragma unroll
                        for (int n = 0; n < 2; ++n) { const f32x4 xv = __builtin_nontemporal_load((const f32x4*)(xr + bj * 128 + n * 16));
                            const f32x4 y = xv + gv[bj][n] * acc[ai][bj][m][n]; acc[ai][bj][m][n] = y;
                            ss += y[0] * y[0] + y[1] * y[1] + y[2] * y[2] + y[3] * y[3]; }
                    ss += __shfl_xor(ss, 16, 64); ss += __shfl_xor(ss, 32, 64);
                    rs[ai][m] = ss; }
        }
        float w0 = 0.f, w1 = 0.f;
#pragma unroll
        for (int jj = 0; jj < 8; ++jj) { if ((jj >> 1) == fq) { if (jj & 1) w1 = rs[jj >> 2][jj & 3]; else w0 = rs[jj >> 2][jj & 3]; } }
        const int jj0 = 2 * fq, jj1 = 2 * fq + 1;
        const int lr0 = (jj0 >> 2) * 128 + wr * 64 + (jj0 & 3) * 16 + fr, lr1 = (jj1 >> 2) * 128 + wr * 64 + (jj1 & 3) * 16 + fr;
        gu64* gp = (gu64*)GRN + (size_t)u.pm * (4 * 4 * 256);
        __hip_atomic_store(gp + ((u.pn * 4 + wc) * 256 + lr0), (1ull << 32) | (unsigned long long)__float_as_uint(w0), __ATOMIC_RELAXED, __HIP_MEMORY_SCOPE_AGENT);
        __hip_atomic_store(gp + ((u.pn * 4 + wc) * 256 + lr1), (1ull << 32) | (unsigned long long)__float_as_uint(w1), __ATOMIC_RELAXED, __HIP_MEMORY_SCOPE_AGENT);
        float t0 = 0.f, t1 = 0.f;
        for (unsigned spins = 0;; ++spins) {
            bool ok = true; t0 = 0.f; t1 = 0.f;
#pragma unroll 4
            for (int k = 0; k < 16; ++k) {
                const unsigned long long a = __hip_atomic_load(gp + (k * 256 + lr0), __ATOMIC_RELAXED, __HIP_MEMORY_SCOPE_AGENT);
                const unsigned long long c = __hip_atomic_load(gp + (k * 256 + lr1), __ATOMIC_RELAXED, __HIP_MEMORY_SCOPE_AGENT);
                ok &= ((a >> 32) == 1ull) & ((c >> 32) == 1ull);
                t0 += __uint_as_float((unsigned)a); t1 += __uint_as_float((unsigned)c); }
            if (__all(ok) || spins > (1u << 20)) break;
            __builtin_amdgcn_s_sleep(4);
        }
        const float ri0 = rsqrtf(t0 * (1.0f / 1024.0f) + 1e-6f), ri1 = rsqrtf(t1 * (1.0f / 1024.0f) + 1e-6f);
        f32x4 fg[2][2];
#pragma unroll
        for (int bj = 0; bj < 2; ++bj)
#pragma unroll
            for (int n = 0; n < 2; ++n) fg[bj][n] = *(const f32x4*)(final_g + col0 + bj * 128 + n * 16);
#pragma unroll
        for (int ai = 0; ai < 2; ++ai)
#pragma unroll
            for (int m = 0; m < 4; ++m) { const int jj = ai * 4 + m; const int row = row0 + ai * 128 + m * 16;
                const float rinv = __shfl((jj & 1) ? ri1 : ri0, fr + 16 * (jj >> 1), 64);
                float* orow = out + (size_t)row * D + col0;
#pragma unroll
                for (int bj = 0; bj < 2; ++bj)
#pragma unroll
                    for (int n = 0; n < 2; ++n) *(f32x4*)(orow + bj * 128 + n * 16) = acc[ai][bj][m][n] * rinv * fg[bj][n]; }
    }
};

__device__ __forceinline__ int win_dstrow(int src) {
    if (src < 1024) return src + 1024;
    if (src < 1536) { const int m = src - 1024; return 2048 + (m >> 7) * 256 + (m & 127); }
    if (src < 2048) return src - 512;
    if (src < 2560) { const int m = src - 2048; return 2048 + (m >> 7) * 256 + 128 + (m & 127); }
    if (src < 3584) { const int m = src - 2560; return 3072 + (m >> 7) * 256 + (m & 127); }
    const int m = src - 3584; return 3072 + (m >> 7) * 256 + 128 + (m & 127);
}
template <bool WIN> __device__ __forceinline__ void transpose_item(const float* src, int src_pitch, int r0, int c0, bf16_t* dst, int dst_row0, int dst_pitch, float* tl, int tid) {
    f32x4 v[8];
#pragma unroll
    for (int i = 0; i < 8; ++i) { const int idx = i * 512 + tid, rr = idx >> 6, c4 = idx & 63; v[i] = __builtin_nontemporal_load((const f32x4*)(src + (size_t)(r0 + rr) * src_pitch + c0 + c4 * 4)); }
#pragma unroll
    for (int i = 0; i < 8; ++i) { const int idx = i * 512 + tid, rr = idx >> 6, c4 = idx & 63;
        *(f32x4*)(tl + rr * 260 + c4 * 4) = v[i]; }
    __syncthreads();
    const int cc = tid >> 1, half = tid & 1;
    const int drow = WIN ? win_dstrow(c0 + cc) : dst_row0 + cc;
    bf16_t* d = dst + (size_t)drow * dst_pitch + r0 + half * 32;
#pragma unroll
    for (int q = 0; q < 4; ++q) { u32x4 o;
#pragma unroll
        for (int i = 0; i < 4; ++i) o[i] = cvt_pk_bf16(tl[(half * 32 + q * 8 + 2 * i) * 260 + cc], tl[(half * 32 + q * 8 + 2 * i + 1) * 260 + cc]);
        *(u32x4*)(d + q * 8) = o; }
}

__device__ void phase0(const Params& p, unsigned char* shm) {
    const int tid0 = opaque_tid();
    float* tab = (float*)shm;
    float* scr = (float*)(shm + 17408);
    unsigned char* ws = p.ws;
    for (int j = tid0; j < 4096; j += 512) tab[TABI(j)] = cospif((float)j * (1.0f / 2048.0f));
    { unsigned long long* grn = (unsigned long long*)(p.ws + OFF_GRN);
      for (size_t i = (size_t)blockIdx.x * 512 + tid0; i < GRN_WORDS; i += (size_t)gridDim.x * 512) grn[i] = 0ull; }
    __syncthreads();
    constexpr int I_MOD = 384, I_TIN = I_MOD + 256, I_TPA = I_TIN + 32, I_TPB = I_TPA + 32, I_TOUT = I_TPB + 64, I_FOLD = I_TOUT + 256, I_WS = I_FOLD + 8, I_DFT = I_WS + 128;
    for (int item = blockIdx.x; item < I_DFT; item += gridDim.x) {
        int tid = tid0; asm volatile("" : "+v"(tid));
        const int w = tid >> 6, lane = tid & 63;
        if (item < I_MOD) {
            const int jt = item % 48, kc = item / 48;
            float* sc = scr; float* red = scr + 2560;
            const int j = jt * 64 + lane;
            float wv[16], cv[5];
#pragma unroll
            for (int kk = 0; kk < 16; ++kk) wv[kk] = __builtin_nontemporal_load(p.w_ada + (size_t)(kc * 128 + w * 16 + kk) * 3072 + j);
#pragma unroll
            for (int i = 0; i < 5; ++i) { const int idx = tid + i * 512, b = idx >> 7, k = kc * 128 + (idx & 127); cv[i] = b < 16 ? p.c_p[b * 1024 + k] : p.c_s[(b - 16) * 1024 + k]; }
#pragma unroll
            for (int i = 0; i < 5; ++i) sc[tid + i * 512] = silu(cv[i]);
            __syncthreads();
            float acc[NB];
#pragma unroll
            for (int b = 0; b < NB; ++b) acc[b] = 0.f;
#pragma unroll
            for (int kk = 0; kk < 16; ++kk) { const int kl = w * 16 + kk;
#pragma unroll
                for (int b = 0; b < NB; ++b) acc[b] += sc[b * 128 + kl] * wv[kk]; }
#pragma unroll
            for (int b = 0; b < NB; ++b) red[(w * NB + b) * 64 + lane] = acc[b];
            __syncthreads();
            for (int idx = tid; idx < NB * 64; idx += 512) { const int b = idx >> 6, l = idx & 63; float s = 0.f;
#pragma unroll
                for (int ww = 0; ww < 8; ++ww) s += red[(ww * NB + b) * 64 + l];
                const int jj = jt * 64 + l; if (kc == 0) s += p.b_ada[jj];
                ((float*)(ws + OFF_MODP))[(size_t)(kc * NB + b) * 3072 + jj] = s; }
        } else if (item < I_TIN) {
            const int it = item - I_MOD, rt = it & 15, ct = it >> 4;
            transpose_item<true>(p.w_in, INW, rt * 64, 512 + ct * 256, (bf16_t*)(ws + OFF_WT1), 0, 1024, scr, tid);
        } else if (item < I_TPA) {
            const int it = item - I_TIN, rt = it & 7, ct = it >> 3;
            transpose_item<false>(p.w_pa, 1024, rt * 64, ct * 256, (bf16_t*)(ws + OFF_WPA), ct * 256, 512, scr, tid);
        } else if (item < I_TPB) {
            const int it = item - I_TPA, rt = it & 7, ct = it >> 3;
            transpose_item<false>(p.w_pb, 1024, rt * 64, ct * 256, (bf16_t*)(ws + OFF_WPB), ct * 256, 512, scr, tid);
        } else if (item < I_TOUT) {
            const int it = item - I_TPB, rt = it & 15, ct = it >> 4;
            transpose_item<false>(p.w_out, 1024, rt * 64, ct * 256, (bf16_t*)(ws + OFF_WOUT), ct * 256, 1024, scr, tid);
        } else if (item < I_FOLD) {
            const int it = item - I_TOUT, dt = it & 31, pg = it >> 5, part = pg >> 2, g = pg & 3, d0 = dt * 32;
            float* wt = scr; float* U = scr + 4096;
            { const int rr = tid >> 4, cc = (tid & 15) * 8; const float* s = p.w_in + (size_t)(d0 + rr) * INW + g * 128 + cc;
              const f32x4 a = __builtin_nontemporal_load((const f32x4*)s), b = __builtin_nontemporal_load((const f32x4*)(s + 4));
#pragma unroll
              for (int i = 0; i < 4; ++i) { wt[rr * 128 + cc + i] = a[i]; wt[rr * 128 + cc + 4 + i] = b[i]; } }
            __syncthreads();
            const int m = tid & 127, ddg = tid >> 7;
            float acc[8];
#pragma unroll
            for (int i = 0; i < 8; ++i) acc[i] = 0.f;
#pragma unroll 2
            for (int c = 0; c < 128; c += 4) { f32x4 tv;
#pragma unroll
                for (int k = 0; k < 4; ++k) { const int idx = (((c + k) * m) & 127) * 32; tv[k] = part ? tab[TABI((idx - 1024) & 4095)] : tab[TABI(idx)]; }
#pragma unroll
                for (int i = 0; i < 8; ++i) { const f32x4 wv = *(const f32x4*)(wt + (ddg * 8 + i) * 128 + c); acc[i] += wv[0] * tv[0] + wv[1] * tv[1] + wv[2] * tv[2] + wv[3] * tv[3]; } }
#pragma unroll
            for (int i = 0; i < 8; ++i) U[(ddg * 8 + i) * 128 + m] = acc[i];
            __syncthreads();
#pragma unroll
            for (int i = 0; i < 8; ++i) acc[i] = 0.f;
#pragma unroll 2
            for (int mm = 0; mm < 128; mm += 4) { f32x4 fv;
#pragma unroll
                for (int k = 0; k < 4; ++k) fv[k] = p.w_fmix[(size_t)(g * 128 + mm + k) * 128 + m];
#pragma unroll
                for (int i = 0; i < 8; ++i) { const f32x4 uv = *(const f32x4*)(U + (ddg * 8 + i) * 128 + mm); acc[i] += uv[0] * fv[0] + uv[1] * fv[1] + uv[2] * fv[2] + uv[3] * fv[3]; } }
            const float sc = 0.08838834764831845f;
            u32x4 o;
#pragma unroll
            for (int i = 0; i < 4; ++i) o[i] = cvt_pk_bf16(acc[2 * i] * sc, acc[2 * i + 1] * sc);
            *(u32x4*)((bf16_t*)(ws + OFF_WT1) + (size_t)(part * 512 + g * 128 + m) * 1024 + d0 + ddg * 8) = o;
        } else if (item < I_WS) {
            const int it = item - I_FOLD; const size_t e = (size_t)it * 8192 + tid * 16; const float* s = p.w_s + e;
            const f32x4 a = *(const f32x4*)s, b = *(const f32x4*)(s + 4), c = *(const f32x4*)(s + 8), d = *(const f32x4*)(s + 12);
            bf16_t* dst = (bf16_t*)(ws + OFF_WSS) + e;
            *(u32x4*)dst = pack8(a, b); *(u32x4*)(dst + 8) = pack8(c, d);
        } else {
            const int r = item - I_WS, k2 = r * 4 + (tid >> 7), e0 = (tid & 127) * 8, part = e0 >> 9;
            float v[8]; bf16_t* dst = (bf16_t*)(ws + OFF_D2) + (size_t)k2 * 1024 + e0;
#pragma unroll
            for (int i = 0; i < 8; ++i) { const int s2 = (e0 + i) & 511, j8 = ((k2 * s2) & 511) * 8; v[i] = part ? tab[TABI((j8 - 1024) & 4095)] : tab[TABI(j8)]; }
            u32x4 o;
#pragma unroll
            for (int i = 0; i < 4; ++i) o[i] = cvt_pk_bf16(v[2 * i], v[2 * i + 1]);
            *(u32x4*)dst = o;
        }
        __syncthreads();
    }
}

__device__ void phase1(const Params& p, unsigned char* shm) {
    const int tid = opaque_tid(), w = tid >> 6, lane = tid & 63;
    float* cA = (float*)shm; float* cB = cA + 1024;
    const float* MODP = (const float*)(p.ws + OFF_MODP); float* GATE = (float*)(p.ws + OFF_GATE);
    bf16_t* H = (bf16_t*)((unsigned char*)p.out + OUT_H);
    for (int b = blockIdx.x; b < NB; b += gridDim.x)
        for (int n = tid; n < 1024; n += 512) { float s = 0.f;
#pragma unroll
            for (int kc = 0; kc < 8; ++kc) s += MODP[(size_t)(kc * NB + b) * 3072 + 2048 + n];
            GATE[b * 1024 + n] = s; }
    for (int g = blockIdx.x; g < NTOK / 64; g += gridDim.x) {
        const int token0 = g * 64, b = batch_of(token0);
        __syncthreads();
        for (int d = tid; d < 1024; d += 512) { float sh = 0.f, sc = 0.f;
#pragma unroll
            for (int kc = 0; kc < 8; ++kc) { sh += MODP[(size_t)(kc * NB + b) * 3072 + d]; sc += MODP[(size_t)(kc * NB + b) * 3072 + 1024 + d]; }
            cA[d] = p.norm_g[d] * (1.f + sc); cB[d] = sh; }
        __syncthreads();
        const f32x4 a0 = *(const f32x4*)(cA + lane * 8), a1 = *(const f32x4*)(cA + lane * 8 + 4), a2 = *(const f32x4*)(cA + 512 + lane * 8), a3 = *(const f32x4*)(cA + 512 + lane * 8 + 4);
        const f32x4 b0 = *(const f32x4*)(cB + lane * 8), b1 = *(const f32x4*)(cB + lane * 8 + 4), b2 = *(const f32x4*)(cB + 512 + lane * 8), b3 = *(const f32x4*)(cB + 512 + lane * 8 + 4);
#pragma unroll 1
        for (int r4 = 0; r4 < 8; r4 += 4) {
            f32x4 v[4][4];
#pragma unroll
            for (int j = 0; j < 4; ++j) { const float* xr = xrow(p, token0 + w * 8 + r4 + j);
                v[j][0] = __builtin_nontemporal_load((const f32x4*)(xr + lane * 8)); v[j][1] = __builtin_nontemporal_load((const f32x4*)(xr + lane * 8 + 4)); v[j][2] = __builtin_nontemporal_load((const f32x4*)(xr + 512 + lane * 8)); v[j][3] = __builtin_nontemporal_load((const f32x4*)(xr + 512 + lane * 8 + 4)); }
#pragma unroll
            for (int j = 0; j < 4; ++j) {
                float ss = 0.f;
#pragma unroll
                for (int i = 0; i < 4; ++i) ss += v[j][0][i] * v[j][0][i] + v[j][1][i] * v[j][1][i] + v[j][2][i] * v[j][2][i] + v[j][3][i] * v[j][3][i];
                ss = wave_sum(ss);
                const float rinv = rsqrtf(ss * (1.0f / 1024.0f) + 1e-6f);
                bf16_t* hr = H + (size_t)(token0 + w * 8 + r4 + j) * 1024;
                *(u32x4*)(hr + lane * 8) = pack8(v[j][0] * rinv * a0 + b0, v[j][1] * rinv * a1 + b1);
                *(u32x4*)(hr + 512 + lane * 8) = pack8(v[j][2] * rinv * a2 + b2, v[j][3] * rinv * a3 + b3);
            }
        }
    }
}

__device__ __forceinline__ int sgu_swz(int c) { return ((c & 3) << 2) | ((c >> 4) & 3); }
__device__ void sgu_chunk(const Params& p, unsigned char* shm, int chunk) {
    const int tid = opaque_tid(), w = tid >> 6, lane = tid & 63;
    const bf16_t* ZR1 = (const bf16_t*)(p.ws + OFF_ZR1);
    const bf16_t* VT = (const bf16_t*)(p.ws + OFF_VT);
    const bf16_t* WSS = (const bf16_t*)(p.ws + OFF_WSS);
    bf16_t* YB = (bf16_t*)((unsigned char*)p.out + OUT_YB);
    float* st = (float*)(shm + 131072);
    float* mr = st + 1024;
    const int t0 = chunk * 128;
    {
        u32x4 raw[16];
#pragma unroll
        for (int it = 0; it < 16; ++it) { const int idx = it * 512 + tid, c = idx >> 4, g = idx & 15; raw[it] = __builtin_nontemporal_load((const u32x4*)(VT + (size_t)c * NTOK + t0 + g * 8)); }
#pragma unroll
        for (int it = 0; it < 16; ++it) { const int idx = it * 512 + tid, c = idx >> 4, g = idx & 15; *(u32x4*)(shm + c * 256 + ((g ^ sgu_swz(c)) << 4)) = raw[it]; }
    }
    const float lg = p.ln_g[tid], lb = p.ln_b[tid];
    const int h = w >> 1, c0 = h * 128 + (w & 1) * 64, fr = lane & 15, fq = lane >> 4;
    u32x4 uu[4][2][2];
#pragma unroll
    for (int ph = 0; ph < 4; ++ph)
#pragma unroll
        for (int pt = 0; pt < 2; ++pt) { const size_t token = (size_t)t0 + ph * 32 + pt * 16 + fr; const bf16_t* zr = ZR1 + token * 1024 + 512 + c0 + fq * 16;
            uu[ph][pt][0] = __builtin_nontemporal_load((const u32x4*)zr); uu[ph][pt][1] = __builtin_nontemporal_load((const u32x4*)(zr + 8)); }
    __syncthreads();
    {
        const int q = tid & 127, qr = tid >> 7;
        float s = 0.f, ss = 0.f;
#pragma unroll 8
        for (int cc = 0; cc < 128; ++cc) { const int c = qr * 128 + cc;
            const float v = __uint_as_float((unsigned)(*(const bf16_t*)(shm + c * 256 + ((((q >> 3) ^ sgu_swz(c)) << 4) | ((q & 7) * 2)))) << 16);
            s += v; ss += v * v; }
        st[(qr * 128 + q) * 2] = s; st[(qr * 128 + q) * 2 + 1] = ss;
    }
    __syncthreads();
    if (tid < 128) { float s = 0.f, ss = 0.f;
#pragma unroll
        for (int qr = 0; qr < 4; ++qr) { s += st[(qr * 128 + tid) * 2]; ss += st[(qr * 128 + tid) * 2 + 1]; }
        const float mean = s * (1.0f / 512.0f); float var = ss * (1.0f / 512.0f) - mean * mean; var = var < 0.f ? 0.f : var;
        mr[tid] = mean; mr[128 + tid] = rsqrtf(var + 1e-6f); }
    __syncthreads();
    st[tid] = lg; st[512 + tid] = lb;
    __syncthreads();
#pragma unroll 4
    for (int it = 0; it < 16; ++it) { const int idx = it * 512 + tid, c = idx >> 4, g = idx & 15;
        unsigned char* ap = shm + c * 256 + ((g ^ sgu_swz(c)) << 4);
        const u32x4 raw = *(const u32x4*)ap;
        const float gam = st[c], bet = st[512 + c];
        const f32x4 m0 = *(const f32x4*)(mr + g * 8), m1 = *(const f32x4*)(mr + g * 8 + 4), r0 = *(const f32x4*)(mr + 128 + g * 8), r1 = *(const f32x4*)(mr + 128 + g * 8 + 4);
        u32x4 o;
        o[0] = cvt_pk_bf16((bf_lo(raw[0]) - m0[0]) * r0[0] * gam + bet, (bf_hi(raw[0]) - m0[1]) * r0[1] * gam + bet);
        o[1] = cvt_pk_bf16((bf_lo(raw[1]) - m0[2]) * r0[2] * gam + bet, (bf_hi(raw[1]) - m0[3]) * r0[3] * gam + bet);
        o[2] = cvt_pk_bf16((bf_lo(raw[2]) - m1[0]) * r1[0] * gam + bet, (bf_hi(raw[2]) - m1[1]) * r1[1] * gam + bet);
        o[3] = cvt_pk_bf16((bf_lo(raw[3]) - m1[2]) * r1[2] * gam + bet, (bf_hi(raw[3]) - m1[3]) * r1[3] * gam + bet);
        *(u32x4*)ap = o; }
    __syncthreads();
    {
        const int arow = c0 + (fr >> 2) * 16 + (fr & 3);
        bf16x8 b[2][4][2];
#pragma unroll
        for (int kk = 0; kk < 4; ++kk)
#pragma unroll
            for (int pt = 0; pt < 2; ++pt) b[0][kk][pt] = *(const bf16x8*)(WSS + (size_t)(h * 128 + pt * 16 + fr) * 128 + kk * 32 + fq * 8);
#pragma unroll
        for (int ph = 0; ph < 4; ++ph) {
            if (ph < 3) {
#pragma unroll
                for (int kk = 0; kk < 4; ++kk)
#pragma unroll
                    for (int pt = 0; pt < 2; ++pt) b[(ph + 1) & 1][kk][pt] = *(const bf16x8*)(WSS + (size_t)(h * 128 + (ph + 1) * 32 + pt * 16 + fr) * 128 + kk * 32 + fq * 8);
            }
            f32x4 acc[4][2];
#pragma unroll
            for (int ct = 0; ct < 4; ++ct)
#pragma unroll
                for (int pt = 0; pt < 2; ++pt) acc[ct][pt] = (f32x4){0.f, 0.f, 0.f, 0.f};
#pragma unroll
            for (int kk = 0; kk < 4; ++kk) {
                bf16x8 a[4];
#pragma unroll
                for (int ct = 0; ct < 4; ++ct) { const int row = arow + ct * 4; a[ct] = *(const bf16x8*)(shm + row * 256 + (((kk * 4 + fq) ^ sgu_swz(row)) << 4)); }
#pragma unroll
                for (int ct = 0; ct < 4; ++ct)
#pragma unroll
                    for (int pt = 0; pt < 2; ++pt) acc[ct][pt] = __builtin_amdgcn_mfma_f32_16x16x32_bf16(a[ct], b[ph & 1][kk][pt], acc[ct][pt], 0, 0, 0);
            }
#pragma unroll
            for (int pt = 0; pt < 2; ++pt) {
                const int pp = ph * 32 + pt * 16 + fr; const size_t token = (size_t)t0 + pp; const float bias = p.b_s[h * 128 + pp];
                u32x4 o[2];
#pragma unroll
                for (int hh = 0; hh < 2; ++hh)
#pragma unroll
                    for (int k2 = 0; k2 < 4; ++k2) {
                        const int ct = 2 * hh + (k2 >> 1), j = 2 * (k2 & 1);
                        const unsigned uw = uu[ph][pt][hh][k2];
                        const float o0 = (acc[ct][pt][j] + bias) * bf_lo(uw);
                        const float o1 = (acc[ct][pt][j + 1] + bias) * bf_hi(uw);
                        o[hh][k2] = cvt_pk_bf16(o0, o1); }
                bf16_t* yp = YB + token * 512 + c0 + fq * 16;
                *(u32x4*)yp = o[0]; *(u32x4*)(yp + 8) = o[1];
            }
        }
    }
    __syncthreads();
}

#define XB_TMO      128
#define XB_XCNT(j)  (256  + 64 * (j))
#define XB_XSUB(j)  (1280 + 64 * (j))
#define XB_XGEN(j)  (2304 + 64 * (j))
#define XB_TOP      3328
#define XB_TOPGEN   3392
#define XB_SPIN_CAP (1u << 18)
__device__ __forceinline__ unsigned xb_ld(unsigned* p)              { return __hip_atomic_load(p, __ATOMIC_RELAXED, __HIP_MEMORY_SCOPE_AGENT); }
__device__ __forceinline__ unsigned xb_add(unsigned* p, unsigned v) { return __hip_atomic_fetch_add(p, v, __ATOMIC_RELAXED, __HIP_MEMORY_SCOPE_AGENT); }
__device__ __forceinline__ unsigned xb_xcc_id() { return (unsigned)__builtin_amdgcn_s_getreg((3 << 11) | 20) & 0xFu; }
#define XB_SPIN(cond, bar) do { unsigned _sp = 0; while (cond) { __builtin_amdgcn_s_sleep(1); \
    if ((++_sp & 255u) == 0u) { if (xb_ld(&(bar)[XB_TMO])) break; if (_sp > XB_SPIN_CAP) { atomicAdd(&(bar)[XB_TMO], 1u); break; } } } } while (0)
struct XcdBarrier { unsigned* bar; unsigned x; volatile LAS unsigned* st; };
__device__ __forceinline__ XcdBarrier xcd_barrier_post(unsigned* bar, volatile LAS unsigned* st) {
    XcdBarrier b; b.bar = bar; b.x = xb_xcc_id(); b.st = st;
    if (threadIdx.x == 0) (void)xb_add(&bar[XB_XCNT(b.x)], 1u);
    return b;
}
__device__ __forceinline__ void xcd_barrier_complete(unsigned* bar, unsigned x, unsigned& nloc, unsigned& nx) {
    const unsigned G = gridDim.x * gridDim.y * gridDim.z;
    unsigned sum, cnt, mine, sp = 0u;
    for (;;) {
        sum = 0u; cnt = 0u; mine = 0u;
#pragma unroll
        for (unsigned j = 0; j < 16; ++j) { const unsigned c = xb_ld(&bar[XB_XCNT(j)]); sum += c; cnt += (c > 0u) ? 1u : 0u; mine = (j == x) ? c : mine; }
        if (sum == G) break;
        __builtin_amdgcn_s_sleep(1);
        if ((++sp & 255u) == 0u) { if (xb_ld(&bar[XB_TMO])) break; if (sp > XB_SPIN_CAP) { atomicAdd(&bar[XB_TMO], 1u); break; } }
    }
    nloc = mine > 0u ? mine : 1u; nx = cnt > 0u ? cnt : 1u;
}
__device__ __forceinline__ void xcd_barrier(const XcdBarrier& b) {
    asm volatile("s_waitcnt vmcnt(0)" ::: "memory");
    __syncthreads();
    if (threadIdx.x == 0) {
        unsigned* bar = b.bar;
        __builtin_amdgcn_s_waitcnt(0);
        unsigned nloc = b.st[0], nx = b.st[1];
        if (nloc == 0u) { xcd_barrier_complete(bar, b.x, nloc, nx); b.st[0] = nloc; b.st[1] = nx; }
        const unsigned old = xb_add(&bar[XB_XSUB(b.x)], 1u);
        const unsigned gen = old / nloc;
        if (old + 1u == (gen + 1u) * nloc) {
            __builtin_amdgcn_fence(__ATOMIC_RELEASE, "agent");
            asm volatile("s_waitcnt vmcnt(0)" ::: "memory");
            const unsigned og = xb_add(&bar[XB_TOP], 1u);
            const unsigned tg = og / nx;
            if (og + 1u == (tg + 1u) * nx) xb_add(&bar[XB_TOPGEN], 1u);
            else XB_SPIN(xb_ld(&bar[XB_TOPGEN]) == tg, bar);
            __builtin_amdgcn_fence(__ATOMIC_ACQUIRE, "agent");
            xb_add(&bar[XB_XGEN(b.x)], 1u);
            asm volatile("s_waitcnt vmcnt(0)" ::: "memory");
        } else {
            XB_SPIN(xb_ld(&bar[XB_XGEN(b.x)]) == gen, bar);
            __builtin_amdgcn_fence(__ATOMIC_ACQUIRE, "agent");
            asm volatile("s_waitcnt vmcnt(0)" ::: "memory");
        }
    }
    __syncthreads();
}

__global__ void __launch_bounds__(512, 2) fwd_megakernel(Params p) {
    extern __shared__ __attribute__((aligned(16))) unsigned char shm[];
    cg::grid_group grid = cg::this_grid();
    LAS unsigned char* lds = (LAS unsigned char*)shm;
    unsigned char* ws = p.ws; unsigned char* ob = (unsigned char*)p.out;
    const int G = gridDim.x, c = blockIdx.x;
    volatile LAS unsigned* bst = (volatile LAS unsigned*)(lds + LDS_BYTES - 16);
    if (threadIdx.x == 0) { bst[0] = 0u; bst[1] = 0u; }
    __syncthreads();
    const XcdBarrier xb = xcd_barrier_post((unsigned*)(ws + OFF_BAR), bst);
    if (p.ws == nullptr) grid.sync();
    const int vc = (G % 8 == 0) ? (c % 8) * (G / 8) + c / 8 : c;

    phase0(p, shm);
    xcd_barrier(xb);
    phase1(p, shm);
    xcd_barrier(xb);
    {
        SchedG1 S; S.H = (const char*)(ob + OUT_H); S.WT1 = (const char*)(ws + OFF_WT1); S.G = G; S.c = c;
        EpiG1 E; E.ZR1 = (bf16_t*)(ws + OFF_ZR1); E.ZR2 = (bf16_t*)(ws + OFF_ZR2); E.PTp = (bf16_t*)(ob + OUT_PT); E.PTs = (bf16_t*)(ob + OUT_PTS); E.VT = (bf16_t*)(ws + OFF_VT);
        pg8::gemm_phase<EpiG1, SchedG1>(lds, 1024, S, E);
    }
    xcd_barrier(xb);
    dft_stage1(p, shm);
    xcd_barrier(xb);
    {
        SchedD2 S; S.D2 = (const char*)(ws + OFF_D2); S.X1T = (const char*)(ws + OFF_X1T); S.G = G; S.c = c;
        EpiD2 E; E.ZR1 = (const bf16_t*)(ws + OFF_ZR1); E.YA = (bf16_t*)(ob + OUT_YA); E.b_fmix = p.b_fmix;
        if (c < 128) sgu_chunk(p, shm, c);
        pg8::gemm_phase<EpiD2, SchedD2>(lds, 1024, S, E);
        __syncthreads();
        if (c >= 128) for (int j = 0; j < 2; ++j) sgu_chunk(p, shm, 128 + (c - 128) * 2 + j);
    }
    xcd_barrier(xb);
    {
        SchedG2 S; S.YA = (const char*)(ob + OUT_YA); S.YB = (const char*)(ob + OUT_YB); S.WPA = (const char*)(ws + OFF_WPA); S.WPB = (const char*)(ws + OFF_WPB); S.G = G; S.c = c;
        EpiG2 E; E.ZR2 = (const bf16_t*)(ws + OFF_ZR2); E.MG = (bf16_t*)(ws + OFF_ZR1);
        pg8::gemm_phase<EpiG2, SchedG2>(lds, 512, S, E);
    }
    xcd_barrier(xb);
    {
        SchedG3 S; S.MG = (const char*)(ws + OFF_ZR1); S.WOUT = (const char*)(ws + OFF_WOUT); S.G = G; S.c = c;
        EpiG3 E; E.x_p = p.x_p; E.x_s = p.x_s; E.GATE = (const float*)(ws + OFF_GATE); E.final_g = p.final_g; E.out = p.out; E.GRN = (unsigned long long*)(ws + OFF_GRN);
        pg8::gemm_phase<EpiG3, SchedG3>(lds, 1024, S, E);
    }
}

extern "C" void kernel_launch(void* const* d_in, const int* in_sizes, int n_in, void* d_out, int out_size, void* d_ws, size_t ws_size, hipStream_t stream) {
    static int grid = 0;
    if (grid == 0) {
        if (n_in != 18 || out_size != NTOK * D || ws_size < WS_END) { fprintf(stderr, "kernel_launch: unexpected shapes (n_in %d out %d ws %zu need %zu)\n", n_in, out_size, ws_size, (size_t)WS_END); grid = -1; return; }
        int dev = 0, cus = 0, per_cu = 0;
        hipGetDevice(&dev);
        hipDeviceGetAttribute(&cus, hipDeviceAttributeMultiprocessorCount, dev);
        if (hipFuncSetAttribute((const void*)fwd_megakernel, hipFuncAttributeMaxDynamicSharedMemorySize, LDS_BYTES) != hipSuccess) { fprintf(stderr, "kernel_launch: hipFuncSetAttribute failed\n"); grid = -1; return; }
        if (hipOccupancyMaxActiveBlocksPerMultiprocessor(&per_cu, (const void*)fwd_megakernel, 512, LDS_BYTES) != hipSuccess || per_cu < 1) { fprintf(stderr, "kernel_launch: occupancy query gave %d\n", per_cu); per_cu = 1; }
        (void)hipGetLastError();
        grid = cus * per_cu;
        if (grid != 256) { fprintf(stderr, "kernel_launch: this build needs a 256-workgroup cooperative grid, got %d\n", grid); grid = -1; return; }
        fprintf(stderr, "kernel_launch: grid %d (cus %d x %d)\n", grid, cus, per_cu);
    }
    if (grid < 0) return;
    Params p{};
    p.x_p = (const float*)d_in[0]; p.x_s = (const float*)d_in[1]; p.c_p = (const float*)d_in[2]; p.c_s = (const float*)d_in[3];
    p.norm_g = (const float*)d_in[4]; p.w_ada = (const float*)d_in[5]; p.b_ada = (const float*)d_in[6]; p.w_in = (const float*)d_in[7];
    p.w_fmix = (const float*)d_in[8]; p.b_fmix = (const float*)d_in[9]; p.ln_g = (const float*)d_in[10]; p.ln_b = (const float*)d_in[11];
    p.w_s = (const float*)d_in[12]; p.b_s = (const float*)d_in[13]; p.w_pa = (const float*)d_in[14]; p.w_pb = (const float*)d_in[15];
    p.w_out = (const float*)d_in[16]; p.final_g = (const float*)d_in[17];
    p.out = (float*)d_out; p.ws = (unsigned char*)d_ws;
    if (hipMemsetAsync((unsigned char*)d_ws + OFF_BAR, 0, BAR_BYTES, stream) != hipSuccess) { fprintf(stderr, "kernel_launch: memset of the barrier words failed\n"); return; }
    void* args[] = {&p};
    hipError_t e = hipLaunchCooperativeKernel((const void*)fwd_megakernel, dim3(grid), dim3(512), args, LDS_BYTES, stream);
    if (e != hipSuccess) fprintf(stderr, "kernel_launch: cooperative launch failed: %s (grid %d)\n", hipGetErrorString(e), grid);
}
```
